# Optimizing an MI355X kernel written in HIP

```python
import jax
import jax.numpy as jnp
from jax import lax
import numpy as np

D_MODEL = 1024
BATCH = 32
SEQ = 2048
DEPTH = 4

N_MIXERS = 4
GROUP_WIDTH = D_MODEL // N_MIXERS
HEADS = 4
HEAD_DIM = GROUP_WIDTH // HEADS
CONV_WIDTH = 3
SGU_CHUNK = 128
GLA_KEY_DIM = HEAD_DIM // 2
GLA_GATE_RANK = 16
GLA_GATE_NORMALIZER = 16.0
LA_CHUNK = 16
D_FF = 2816
N_EXPERTS = 8
TOP_K = 2
D_FF_EXPERT = 3584
N_MOD = 6
N_DENSE_LAYERS = (DEPTH + 1) // 2
N_MOE_LAYERS = DEPTH // 2
EPS = 1e-6
PROJ_SIZES = (
    GROUP_WIDTH, GROUP_WIDTH, GROUP_WIDTH,
    GROUP_WIDTH, GROUP_WIDTH,
    HEADS * GLA_KEY_DIM, HEADS * GLA_KEY_DIM, GROUP_WIDTH,
    GLA_GATE_RANK, GROUP_WIDTH,
    GROUP_WIDTH, GROUP_WIDTH, GROUP_WIDTH, GROUP_WIDTH,
)
IN_PROJ_WIDTH = sum(PROJ_SIZES)

kernel_name = "hybrid_parallel_groups_adaln_moe_trunk"


def rms_norm(x, g):
    xf = x.astype(jnp.float32)
    y = xf * lax.rsqrt(jnp.mean(xf * xf, axis=-1, keepdims=True) + EPS)
    return y.astype(x.dtype) * g


def causal_depthwise_conv(x, w):
    s = x.shape[1]
    xp = jnp.pad(x, ((0, 0), (CONV_WIDTH - 1, 0), (0, 0)))
    return sum(xp[:, k:k + s] * w[k] for k in range(CONV_WIDTH))


def short_conv_mixer(b_gate, c_gate, x_in, w_conv):
    return b_gate * causal_depthwise_conv(c_gate * x_in, w_conv)


def spatial_gating_mixer(u, v, norm_g, w_s, b_s):
    bn, s, _ = v.shape
    n = s // SGU_CHUNK
    vf = v.astype(jnp.float32)
    mu = jnp.mean(vf, axis=-1, keepdims=True)
    var = jnp.mean(jnp.square(vf - mu), axis=-1, keepdims=True)
    vn = ((vf - mu) * lax.rsqrt(var + EPS)).astype(v.dtype) * norm_g
    vc = vn.reshape(bn, n, SGU_CHUNK, HEADS, HEAD_DIM)
    causal = jnp.tril(jnp.ones((SGU_CHUNK, SGU_CHUNK), dtype=bool))
    ws = jnp.where(causal[None], w_s, 0.0)
    mixed = jnp.einsum('hts,bnshd->bnthd', ws, vc) + b_s.T[None, None, :, :, None]
    return u * mixed.reshape(bn, s, GROUP_WIDTH)


def chunk_gated_linear_attention(q, k, v, log_a):
    bn, s, h, kd = q.shape
    vd = v.shape[-1]
    n = s // LA_CHUNK
    f32 = jnp.float32
    q, k, v, log_a = (t.astype(f32).reshape(bn, n, LA_CHUNK, h, t.shape[-1]) for t in (q, k, v, log_a))
    b = jnp.cumsum(log_a, axis=2)
    mid = LA_CHUNK // 2
    b_ref = b[:, :, mid:mid + 1]
    scores = jnp.einsum('bnihk,bnjhk->bnhij', q * jnp.exp(b - b_ref), k * jnp.exp(b_ref - b))
    causal = jnp.tril(jnp.ones((LA_CHUNK, LA_CHUNK), dtype=bool))
    scores = jnp.where(causal, scores, 0.0)
    o_intra = jnp.einsum('bnhij,bnjhv->bnihv', scores, v)
    b_last = b[:, :, -1:]
    k_upd = k * jnp.exp(b_last - b)
    decay = jnp.exp(b_last[:, :, 0])

    def step(state, xs):
        d, kc, vc = xs
        new_state = d[..., None] * state + jnp.einsum('bjhk,bjhv->bhkv', kc, vc)
        return new_state, state

    s0 = jnp.zeros((bn, h, kd, vd), f32)
    _, s_prev = lax.scan(step, s0, (jnp.moveaxis(decay, 1, 0), jnp.moveaxis(k_upd, 1, 0), jnp.moveaxis(v, 1, 0)))
    o_inter = jnp.einsum('bnihk,nbhkv->bnihv', q * jnp.exp(b), s_prev)
    return (o_intra + o_inter).reshape(bn, s, h, vd)


def gla_mixer(q, k, v, g_lowrank, r, w_gate, b_gate, norm_g):
    bn, s, _ = q.shape
    log_a = jax.nn.log_sigmoid((g_lowrank @ w_gate + b_gate).astype(jnp.float32)) / GLA_GATE_NORMALIZER
    o = chunk_gated_linear_attention(
        q.reshape(bn, s, HEADS, GLA_KEY_DIM) * (GLA_KEY_DIM ** -0.5),
        k.reshape(bn, s, HEADS, GLA_KEY_DIM),
        v.reshape(bn, s, HEADS, HEAD_DIM),
        log_a.reshape(bn, s, HEADS, GLA_KEY_DIM))
    o = rms_norm(o.astype(q.dtype), norm_g)
    return o.reshape(bn, s, GROUP_WIDTH) * jax.nn.silu(r)


def hgrn2_mixer(q, f_logit, i_in, g, lower_bound, norm_g):
    bn, s, _ = q.shape
    f = lower_bound + (1.0 - lower_bound) * jax.nn.sigmoid(f_logit.astype(jnp.float32))
    o = chunk_gated_linear_attention(
        q.reshape(bn, s, HEADS, HEAD_DIM),
        (1.0 - f).reshape(bn, s, HEADS, HEAD_DIM),
        i_in.reshape(bn, s, HEADS, HEAD_DIM),
        jnp.log(f).reshape(bn, s, HEADS, HEAD_DIM))
    o = rms_norm(o.astype(q.dtype), norm_g)
    return o.reshape(bn, s, GROUP_WIDTH) * jax.nn.silu(g)


def swiglu(x, w1, w3, w2):
    return (jax.nn.silu(x @ w1) * (x @ w3)) @ w2


def moe_swiglu(x, w_router, w1, w3, w2):
    bn, s, d = x.shape
    t = x.reshape(bn * s, d)
    logits = (t @ w_router).astype(jnp.float32)
    top_val, top_idx = lax.top_k(logits, TOP_K)
    top_w = jax.nn.softmax(top_val, axis=-1)
    combine = jnp.sum(jax.nn.one_hot(top_idx, N_EXPERTS, dtype=jnp.float32) * top_w[..., None], axis=1)
    out = jnp.zeros_like(t)
    for e in range(N_EXPERTS):
        out = out + combine[:, e:e + 1].astype(t.dtype) * swiglu(t, w1[e], w3[e], w2[e])
    return out.reshape(bn, s, d)


def setup_inputs(seed: int = 0) -> dict:
    key = jax.random.key(seed)
    ks = jax.random.split(key, 25)
    f32 = jnp.float32

    def normal(k, shape, scale):
        return scale * jax.random.normal(k, shape, f32)

    def gain(k, shape):
        return 1.0 + normal(k, shape, 0.02)

    L = DEPTH
    return {
        "x": normal(ks[0], (BATCH, SEQ, D_MODEL), 1.0),
        "c": normal(ks[1], (BATCH, D_MODEL), 1.0),
        "norm_mix_g": gain(ks[2], (L, D_MODEL)),
        "norm_ffn_g": gain(ks[3], (L, D_MODEL)),
        "final_norm_g": gain(ks[4], (D_MODEL,)),
        "w_ada": normal(ks[5], (L, D_MODEL, N_MOD * D_MODEL), 0.5 * D_MODEL ** -0.5),
        "b_ada": normal(ks[6], (L, N_MOD * D_MODEL), 0.02),
        "w_in": normal(ks[7], (L, D_MODEL, IN_PROJ_WIDTH), D_MODEL ** -0.5),
        "w_out": normal(ks[8], (L, N_MIXERS * GROUP_WIDTH, D_MODEL), (N_MIXERS * GROUP_WIDTH) ** -0.5),
        "conv_w": normal(ks[9], (L, CONV_WIDTH, GROUP_WIDTH), CONV_WIDTH ** -0.5),
        "sgu_norm_g": gain(ks[10], (L, GROUP_WIDTH)),
        "sgu_w": normal(ks[11], (L, HEADS, SGU_CHUNK, SGU_CHUNK), SGU_CHUNK ** -0.5),
        "sgu_b": gain(ks[12], (L, HEADS, SGU_CHUNK)),
        "gla_w_gate": normal(ks[13], (L, GLA_GATE_RANK, HEADS * GLA_KEY_DIM), GLA_GATE_RANK ** -0.5),
        "gla_b_gate": normal(ks[14], (L, HEADS * GLA_KEY_DIM), 0.1),
        "gla_norm_g": gain(ks[15], (L, HEAD_DIM)),
        "hgrn_lower_bounds": normal(ks[16], (L, GROUP_WIDTH), 0.1),
        "hgrn_norm_g": gain(ks[17], (L, HEAD_DIM)),
        "ffn_w1": normal(ks[18], (N_DENSE_LAYERS, D_MODEL, D_FF), D_MODEL ** -0.5),
        "ffn_w3": normal(ks[19], (N_DENSE_LAYERS, D_MODEL, D_FF), D_MODEL ** -0.5),
        "ffn_w2": normal(ks[20], (N_DENSE_LAYERS, D_FF, D_MODEL), D_FF ** -0.5),
        "moe_router": normal(ks[21], (N_MOE_LAYERS, D_MODEL, N_EXPERTS), D_MODEL ** -0.5),
        "moe_w1": normal(ks[22], (N_MOE_LAYERS, N_EXPERTS, D_MODEL, D_FF_EXPERT), D_MODEL ** -0.5),
        "moe_w3": normal(ks[23], (N_MOE_LAYERS, N_EXPERTS, D_MODEL, D_FF_EXPERT), D_MODEL ** -0.5),
        "moe_w2": normal(ks[24], (N_MOE_LAYERS, N_EXPERTS, D_FF_EXPERT, D_MODEL), D_FF_EXPERT ** -0.5),
    }


def reference(x, c, norm_mix_g, norm_ffn_g, final_norm_g, w_ada, b_ada, w_in, w_out, conv_w,
              sgu_norm_g, sgu_w, sgu_b, gla_w_gate, gla_b_gate, gla_norm_g, hgrn_lower_bounds,
              hgrn_norm_g, ffn_w1, ffn_w3, ffn_w2, moe_router, moe_w1, moe_w3, moe_w2):
    split_points = np.cumsum(PROJ_SIZES)[:-1].tolist()
    cond = jax.nn.silu(c)
    lb_cum = jnp.cumsum(jax.nn.softmax(hgrn_lower_bounds.astype(jnp.float32), axis=0), axis=0)
    lower_bounds = lb_cum - lb_cum[0]
    for layer in range(DEPTH):
        mod = cond @ w_ada[layer] + b_ada[layer]
        shift_m, scale_m, gate_m, shift_f, scale_f, gate_f = [m[:, None, :] for m in jnp.split(mod, N_MOD, axis=-1)]
        h = rms_norm(x, norm_mix_g[layer]) * (1.0 + scale_m) + shift_m
        (cb, cc, cx, su, sv, aq, ak, av, ag, ar, hq, hf, hi, hg) = jnp.split(h @ w_in[layer], split_points, axis=-1)
        y_conv = short_conv_mixer(cb, cc, cx, conv_w[layer])
        y_sgu = spatial_gating_mixer(su, sv, sgu_norm_g[layer], sgu_w[layer], sgu_b[layer])
        y_gla = gla_mixer(aq, ak, av, ag, ar, gla_w_gate[layer], gla_b_gate[layer], gla_norm_g[layer])
        y_hgrn = hgrn2_mixer(hq, hf, hi, hg, lower_bounds[layer], hgrn_norm_g[layer])
        mixed = jnp.concatenate([y_conv, y_sgu, y_gla, y_hgrn], axis=-1) @ w_out[layer]
        x = x + gate_m * mixed
        h = rms_norm(x, norm_ffn_g[layer]) * (1.0 + scale_f) + shift_f
        idx = layer // 2
        if layer % 2 == 0:
            y = swiglu(h, ffn_w1[idx], ffn_w3[idx], ffn_w2[idx])
        else:
            y = moe_swiglu(h, moe_router[idx], moe_w1[idx], moe_w3[idx], moe_w2[idx])
        x = x + gate_f * y
    return rms_norm(x, final_norm_g)
```

```cpp
#include <hip/hip_runtime.h>
#include <cstdio>
#include <cstdint>

namespace pg8 {
#define PG8_LAS __attribute__((address_space(3)))
typedef unsigned short bf16_t;
typedef short bf16x8 __attribute__((ext_vector_type(8)));
typedef float f32x4 __attribute__((ext_vector_type(4)));
typedef unsigned u32x4 __attribute__((ext_vector_type(4)));
constexpr int BM = 256, BK = 64, HALF = 128, HTB = HALF * BK * 2  , STAGE_BYTES = 8 * HTB, NXCD = 8, WGM = 8;

__host__ __device__ __forceinline__ int lds_byte(int r, int c) { const int st = (r >> 4) * 2 + (c >> 5), rr = r & 15, cc = c & 31, ob = rr * 64 + cc * 2; return st * 1024 + (ob ^ (((ob >> 9) & 1) << 5)); }
__host__ __device__ __forceinline__ void stage_rc(int b, int& R, int& C) { const int st = b / 1024, sb = b % 1024, swz = sb ^ (((sb >> 9) & 1) << 5); R = (st >> 1) * 16 + swz / 64; C = (st & 1) * 32 + (swz % 64) / 2; }
__host__ __device__ __forceinline__ int perm32(int rho) { const int n = rho >> 4, i = rho & 15; return 8 * (i >> 2) + 4 * n + (i & 3); }

struct Unit { int pm, pn; };
struct Gemm { const bf16_t* A; const bf16_t* Bt; int K; };

struct StaticOrder {
    static constexpr bool GATHER = false;
    int nM, nN, nwg, G, c;
    __host__ __device__ void init(int M, int N, int G_, int c_) { nM = M / BM; nN = N / BM; nwg = nM * nN; G = G_; c = c_; }
    __host__ __device__ bool next(int i, Unit& u) const {
        const long L = (long)i * G + c; if (L >= nwg) return false;
        int wgid = (int)L; { const int q = nwg / NXCD, r = nwg % NXCD, xcd = wgid % NXCD, off = wgid / NXCD; wgid = (xcd < r ? xcd * (q + 1) : r * (q + 1) + (xcd - r) * q) + off; }
        const int nig = WGM * nN, gid = wgid / nig, fm = gid * WGM, gsz = (nM - fm) < WGM ? (nM - fm) : WGM;
        u.pm = fm + ((wgid % nig) % gsz); u.pn = (wgid % nig) / gsz; return true;
    }
    __device__ __forceinline__ const char* a_base(const Gemm& g, const Unit& u) const { return (const char*)g.A + (size_t)u.pm * ((size_t)BM * g.K * 2); }
    __device__ __forceinline__ const char* b_base(const Gemm& g, const Unit& u) const { return (const char*)g.Bt + (size_t)u.pn * ((size_t)BM * g.K * 2); }
    __device__ __forceinline__ int row_index(const Unit&, int) const { return 0; }
};

template <bool GATH> struct MoeOrder {
    static constexpr bool GATHER = GATH;
    StaticOrder so; int pan0; int ps1, ps2, ps3, ps4, ps5, ps6, ps7; size_t estride  ; const int* rowmap;
    __device__ __forceinline__ bool next(int i, Unit& u) const { return so.next(i, u); }
    __device__ __forceinline__ int expert_of(int p) const { return (p >= ps1) + (p >= ps2) + (p >= ps3) + (p >= ps4) + (p >= ps5) + (p >= ps6) + (p >= ps7); }
    __device__ __forceinline__ const char* a_base(const Gemm& g, const Unit& u) const { return GATH ? (const char*)g.A : (const char*)g.A + (size_t)u.pm * ((size_t)BM * g.K * 2); }
    __device__ __forceinline__ const char* b_base(const Gemm& g, const Unit& u) const { return (const char*)g.Bt + (size_t)expert_of(pan0 + u.pm) * estride + (size_t)u.pn * ((size_t)BM * g.K * 2); }
    __device__ __forceinline__ int row_index(const Unit& u, int r) const { return rowmap[(size_t)(pan0 + u.pm) * BM + r]; }
};

__device__ __forceinline__ unsigned cvt_pk_bf16(float lo, float hi) { unsigned r; asm volatile("v_cvt_pk_bf16_f32 %0, %1, %2" : "=v"(r) : "v"(lo), "v"(hi)); return r; }
__device__ __forceinline__ float silu_f(float x) { return x * __builtin_amdgcn_rcpf(1.0f + __expf(-x)); }

struct EpiBf16 {
    static constexpr bool PERM = true;
    bf16_t* O; int ldc;
    __device__ __forceinline__ void operator()(const f32x4 (&acc)[2][2][4][2], const Unit& u, int wr, int wc, int fr, int fq) const {
        const int row0 = u.pm * BM + wr * 64 + fr, col0 = u.pn * BM + wc * 32 + 8 * fq;
#pragma unroll
        for (int ai = 0; ai < 2; ++ai)
#pragma unroll
            for (int m = 0; m < 4; ++m) { bf16_t* rowp = O + (size_t)(row0 + ai * HALF + m * 16) * ldc + col0;
#pragma unroll
                for (int bj = 0; bj < 2; ++bj) { const f32x4 v0 = acc[ai][bj][m][0], v1 = acc[ai][bj][m][1];
                    u32x4 w; w.x = cvt_pk_bf16(v0[0], v0[1]); w.y = cvt_pk_bf16(v0[2], v0[3]); w.z = cvt_pk_bf16(v1[0], v1[1]); w.w = cvt_pk_bf16(v1[2], v1[3]);
                    *(u32x4*)(rowp + bj * HALF) = w; } }
    }
};
struct EpiSwiglu {
    static constexpr bool PERM = true;
    bf16_t* O; int ldc;
    __device__ __forceinline__ void operator()(const f32x4 (&acc)[2][2][4][2], const Unit& u, int wr, int wc, int fr, int fq) const {
        const int row0 = u.pm * BM + wr * 64 + fr, col0 = u.pn * HALF + wc * 32 + 8 * fq;
#pragma unroll
        for (int ai = 0; ai < 2; ++ai)
#pragma unroll
            for (int m = 0; m < 4; ++m) { bf16_t* rowp = O + (size_t)(row0 + ai * HALF + m * 16) * ldc + col0;
                const f32x4 g0 = acc[ai][0][m][0], g1 = acc[ai][0][m][1], u0 = acc[ai][1][m][0], u1 = acc[ai][1][m][1];
                float h[8];
#pragma unroll
                for (int i = 0; i < 4; ++i) { h[i] = silu_f(g0[i]) * u0[i]; h[4 + i] = silu_f(g1[i]) * u1[i]; }
                u32x4 w; w.x = cvt_pk_bf16(h[0], h[1]); w.y = cvt_pk_bf16(h[2], h[3]); w.z = cvt_pk_bf16(h[4], h[5]); w.w = cvt_pk_bf16(h[6], h[7]);
                *(u32x4*)rowp = w; }
    }
};
struct EpiRes {
    static constexpr bool PERM = false;
    const float* xin; float* xout; const float* gate; int gstride;
    __device__ __forceinline__ void operator()(const f32x4 (&acc)[2][2][4][2], const Unit& u, int wr, int wc, int fr, int fq) const {
        const int row0 = u.pm * BM + wr * 64 + fr, col0 = u.pn * BM + wc * 32 + 4 * fq;
        const float* gp = gate + (size_t)(u.pm >> 3) * gstride + col0;
        f32x4 gv[2][2];
#pragma unroll
        for (int bj = 0; bj < 2; ++bj)
#pragma unroll
            for (int n = 0; n < 2; ++n) gv[bj][n] = *(const f32x4*)(gp + bj * HALF + n * 16);
#pragma unroll
        for (int ai = 0; ai < 2; ++ai)
#pragma unroll
            for (int m = 0; m < 4; ++m) { const size_t off = (size_t)(row0 + ai * HALF + m * 16) * 1024 + col0;
#pragma unroll
                for (int bj = 0; bj < 2; ++bj)
#pragma unroll
                    for (int n = 0; n < 2; ++n) { const f32x4 xi = *(const f32x4*)(xin + off + bj * HALF + n * 16); *(f32x4*)(xout + off + bj * HALF + n * 16) = xi + gv[bj][n] * acc[ai][bj][m][n]; }
                if (m & 1) asm volatile("" ::: "memory"); }
    }
};

template <class Epi, class Sched, bool ALIGN_EPI>
__device__ __forceinline__ void gemm_phase(PG8_LAS unsigned char* lds, PG8_LAS int* rowtab, const Gemm g, const Sched& S, const Epi& E) {
    int tid_ = threadIdx.x; asm volatile("" : "+v"(tid_));
    const int tid = tid_, wid = __builtin_amdgcn_readfirstlane(tid >> 6), lane = tid & 63, wr = wid >> 2, wc = wid & 3, fr = lane & 15, fq = lane >> 4;
    const int K = g.K, nt = K / BK;
    unsigned voffA[2], voffB[2];
#pragma unroll
    for (int i = 0; i < 2; ++i) { int R, C; stage_rc(tid * 16 + i * 8192, R, C); const int Rb = Epi::PERM ? ((R & ~31) + perm32(R & 31)) : R;
        voffA[i] = (unsigned)(R * K + C) * 2u; voffB[i] = (unsigned)(Rb * K + C) * 2u; }
    const size_t kstep = (size_t)(BK * 2);
    const size_t hstep = (size_t)HALF * K * 2;
    const unsigned ldsw = (unsigned)wid * 1024u;
    const int aoff = lds_byte(wr * 64 + fr, fq * 8), boff = lds_byte(wc * 32 + fr, fq * 8);
#define PG8_SA(b, h) (((b) * 2 + (h)) * HTB)
#define PG8_SB(b, h) ((4 + (b) * 2 + (h)) * HTB)
#define PG8_STAGE(bufoff, gbase, voff) do { _Pragma("unroll") for (int _i = 0; _i < 2; ++_i) \
        __builtin_amdgcn_global_load_lds((const unsigned*)((const char*)(gbase) + (voff)[_i]), (PG8_LAS unsigned*)(lds + (bufoff) + ldsw + _i * 8192), 16, 0, 0); } while (0)
#define PG8_STA(bufoff, h, ptr, GO) do { if constexpr (Sched::GATHER) { PG8_STAGE(bufoff, ptr, GO[h]); } else { PG8_STAGE(bufoff, (ptr) + (h) * hstep, voffA); } } while (0)
#define PG8_LDA(dst, b, h) do { _Pragma("unroll") for (int m = 0; m < 4; ++m) _Pragma("unroll") for (int k = 0; k < 2; ++k) dst[m][k] = *(const PG8_LAS bf16x8*)(lds + PG8_SA(b, h) + aoff + m * 2048 + k * 1024); } while (0)
#define PG8_LDB(dst, b, h) do { _Pragma("unroll") for (int n = 0; n < 2; ++n) _Pragma("unroll") for (int k = 0; k < 2; ++k) dst[n][k] = *(const PG8_LAS bf16x8*)(lds + PG8_SB(b, h) + boff + n * 2048 + k * 1024); } while (0)
#define PG8_MMA(ai, bj, At, Bt) do { __builtin_amdgcn_s_setprio(1); _Pragma("unroll") for (int m = 0; m < 4; ++m) _Pragma("unroll") for (int n = 0; n < 2; ++n) _Pragma("unroll") for (int k = 0; k < 2; ++k) \
        acc[ai][bj][m][n] = __builtin_amdgcn_mfma_f32_16x16x32_bf16(Bt[n][k], At[m][k], acc[ai][bj][m][n], 0, 0, 0); __builtin_amdgcn_s_setprio(0); } while (0)
#define PG8_WAIT_V(n) asm volatile("s_waitcnt vmcnt(" #n ")" ::: "memory")
#define PG8_WAIT_L(n) asm volatile("s_waitcnt lgkmcnt(" #n ")" ::: "memory")
#define PG8_BAR __builtin_amdgcn_s_barrier()
#define PG8_SCHED __builtin_amdgcn_sched_barrier(0)
    Unit cur, nxt; int ui = 0;
    if (!S.next(0, cur)) return;
    unsigned gc[2][2], gs[2][2];
    if constexpr (Sched::GATHER) {
        Unit tu;
        for (int i = 0; i < 8 && S.next(i, tu); ++i) if (tid < 256) rowtab[i * 256 + tid] = S.row_index(tu, tid);
        asm volatile("s_waitcnt vmcnt(0) lgkmcnt(0)" ::: "memory"); PG8_BAR; asm volatile("" ::: "memory");
#pragma unroll
        for (int h = 0; h < 2; ++h)
#pragma unroll
            for (int i = 0; i < 2; ++i) { int R, C; stage_rc(tid * 16 + i * 8192, R, C); gc[h][i] = (unsigned)rowtab[h * HALF + R] * (unsigned)(K * 2) + (unsigned)C * 2u; gs[h][i] = gc[h][i]; }
    } else {
#pragma unroll
        for (int h = 0; h < 2; ++h)
#pragma unroll
            for (int i = 0; i < 2; ++i) { gc[h][i] = 0u; gs[h][i] = 0u; }
    }
    f32x4 acc[2][2][4][2];
#pragma unroll
    for (int a = 0; a < 2; ++a)
#pragma unroll
        for (int b = 0; b < 2; ++b)
#pragma unroll
            for (int m = 0; m < 4; ++m)
#pragma unroll
                for (int n = 0; n < 2; ++n) acc[a][b][m][n] = (f32x4){0.f, 0.f, 0.f, 0.f};
    bf16x8 At[4][2], B0[2][2], B1[2][2];
    const char* cA = S.a_base(g, cur); const char* cB = S.b_base(g, cur);
    PG8_STAGE(PG8_SB(0, 0), cB, voffB); PG8_STAGE(PG8_SB(0, 1), cB + hstep, voffB); PG8_STA(PG8_SA(0, 0), 0, cA, gc); PG8_STA(PG8_SA(0, 1), 1, cA, gc);
    if (wr == 1) PG8_BAR;
    PG8_WAIT_V(2); PG8_BAR;
    PG8_STAGE(PG8_SB(1, 0), cB + kstep, voffB); PG8_STA(PG8_SA(1, 0), 0, cA + kstep, gc); PG8_STAGE(PG8_SB(1, 1), cB + hstep + kstep, voffB);
    PG8_WAIT_V(6); PG8_BAR;
    for (;;) {
        const bool has_next = S.next(ui + 1, nxt);
        const char* nA = has_next ? S.a_base(g, nxt) : cA; const char* nB = has_next ? S.b_base(g, nxt) : cB;
        for (int t = 0; t < nt; t += 2) {
            const bool last = (t == nt - 2);
            const char* a1 = cA + (size_t)(t + 1) * kstep;
            const char* a2 = last ? nA : cA + (size_t)(t + 2) * kstep; const char* b2 = last ? nB : cB + (size_t)(t + 2) * kstep;
            const char* a3 = a2 + kstep; const char* b3 = b2 + kstep;
            if constexpr (Sched::GATHER) {
                if (last && has_next) {
#pragma unroll
                    for (int h = 0; h < 2; ++h)
#pragma unroll
                        for (int i = 0; i < 2; ++i) { int R, C; stage_rc(tid * 16 + i * 8192, R, C); gs[h][i] = (unsigned)rowtab[(ui + 1) * 256 + h * HALF + R] * (unsigned)(K * 2) + (unsigned)C * 2u; }
                }
            }
            PG8_LDB(B0, 0, 0); PG8_LDB(B1, 0, 1); PG8_SCHED; PG8_LDA(At, 0, 0); PG8_STA(PG8_SA(1, 1), 1, a1, gc);
            PG8_WAIT_V(8); PG8_WAIT_L(0); PG8_BAR; PG8_MMA(0, 0, At, B0); PG8_MMA(0, 1, At, B1); PG8_BAR; PG8_SCHED;
            PG8_LDA(At, 0, 1); PG8_STAGE(PG8_SB(0, 0), b2, voffB); PG8_STAGE(PG8_SB(0, 1), b2 + hstep, voffB); PG8_STA(PG8_SA(0, 0), 0, a2, gs);
            PG8_WAIT_V(8); PG8_WAIT_L(0); PG8_BAR; PG8_MMA(1, 0, At, B0); PG8_MMA(1, 1, At, B1); PG8_BAR; PG8_SCHED;
            PG8_LDB(B0, 1, 0); PG8_LDB(B1, 1, 1); PG8_SCHED; PG8_LDA(At, 1, 0); PG8_STA(PG8_SA(0, 1), 1, a2, gs);
            PG8_WAIT_V(8); PG8_WAIT_L(0); PG8_BAR; PG8_MMA(0, 0, At, B0); PG8_MMA(0, 1, At, B1); PG8_BAR; PG8_SCHED;
            PG8_LDA(At, 1, 1); PG8_STAGE(PG8_SB(1, 0), b3, voffB); PG8_STAGE(PG8_SB(1, 1), b3 + hstep, voffB); PG8_STA(PG8_SA(1, 0), 0, a3, gs);
            PG8_WAIT_V(8); PG8_WAIT_L(0); PG8_BAR; PG8_MMA(1, 0, At, B0); PG8_MMA(1, 1, At, B1); PG8_BAR; PG8_SCHED;
        }
        if constexpr (ALIGN_EPI) { if (wr == 0) PG8_BAR; }
        E(acc, cur, wr, wc, fr, fq);
        if (!has_next) break;
#pragma unroll
        for (int a = 0; a < 2; ++a)
#pragma unroll
            for (int b = 0; b < 2; ++b)
#pragma unroll
                for (int m = 0; m < 4; ++m)
#pragma unroll
                    for (int n = 0; n < 2; ++n) acc[a][b][m][n] = (f32x4){0.f, 0.f, 0.f, 0.f};
        cur = nxt; cA = nA; cB = nB; ++ui;
        if constexpr (Sched::GATHER) {
#pragma unroll
            for (int h = 0; h < 2; ++h)
#pragma unroll
                for (int i = 0; i < 2; ++i) gc[h][i] = gs[h][i];
        }
        if constexpr (ALIGN_EPI) { if (wr == 1) PG8_BAR; }
    }
    PG8_WAIT_V(0);
    if constexpr (!ALIGN_EPI) { if (wr == 0) PG8_BAR; }
    PG8_BAR;
#undef PG8_SA
#undef PG8_SB
#undef PG8_STAGE
#undef PG8_STA
#undef PG8_LDA
#undef PG8_LDB
#undef PG8_MMA
#undef PG8_WAIT_V
#undef PG8_WAIT_L
#undef PG8_BAR
#undef PG8_SCHED
}
}

#define GAS __attribute__((address_space(1)))
#define LAS __attribute__((address_space(3)))
typedef unsigned short bf16;
typedef unsigned v4u __attribute__((ext_vector_type(4)));
typedef float f32x4 __attribute__((ext_vector_type(4)));
typedef short bf16x8 __attribute__((ext_vector_type(8)));
typedef GAS unsigned gu32;
typedef GAS unsigned long long gu64;
#define RLX_AGENT __ATOMIC_RELAXED, __HIP_MEMORY_SCOPE_AGENT
#define LDS_WAIT() asm volatile("s_waitcnt lgkmcnt(0)" ::: "memory")
#define VM_WAIT() asm volatile("s_waitcnt vmcnt(0)" ::: "memory")
__device__ __forceinline__ unsigned long long rt() { return __builtin_amdgcn_s_memrealtime(); }
__device__ __forceinline__ unsigned f2bf(float f) { unsigned u = __builtin_bit_cast(unsigned, f); return (u + 0x7fffu + ((u >> 16) & 1u)) >> 16; }
__device__ __forceinline__ unsigned pk2(float lo, float hi) { return f2bf(lo) | (f2bf(hi) << 16); }

#define XB_TMO      128
#define XB_XCNT(j)  (256  + 64 * (j))
#define XB_XSUB(j)  (1280 + 64 * (j))
#define XB_XGEN(j)  (2304 + 64 * (j))
#define XB_TOP      3328
#define XB_TOPGEN   3392
#define XCD_BAR_WORDS 3456
#define XB_SPIN_CAP (1u << 18)

__device__ __forceinline__ unsigned xb_ld(unsigned* p)              { return __hip_atomic_load(p, __ATOMIC_RELAXED, __HIP_MEMORY_SCOPE_AGENT); }
__device__ __forceinline__ unsigned xb_add(unsigned* p, unsigned v) { return __hip_atomic_fetch_add(p, v, __ATOMIC_RELAXED, __HIP_MEMORY_SCOPE_AGENT); }
__device__ __forceinline__ unsigned xb_xcc_id() { return (unsigned)__builtin_amdgcn_s_getreg((3 << 11) | 20) & 0xFu; }
#define XB_SPIN(cond, bar) do { unsigned _sp = 0; while (cond) { __builtin_amdgcn_s_sleep(1); \
    if ((++_sp & 255u) == 0u) { if (xb_ld(&(bar)[XB_TMO])) break; if (_sp > XB_SPIN_CAP) { atomicAdd(&(bar)[XB_TMO], 1u); break; } } } } while (0)

struct XcdBarrier {
    unsigned* bar; unsigned x;
    volatile LAS unsigned* st;
};

__device__ __forceinline__ XcdBarrier xcd_barrier_post(unsigned* bar, volatile LAS unsigned* st) {
    XcdBarrier b; b.bar = bar; b.x = xb_xcc_id(); b.st = st;
    if (threadIdx.x == 0) (void)xb_add(&bar[XB_XCNT(b.x)], 1u);
    return b;
}
__device__ __forceinline__ void xcd_barrier_complete(unsigned* bar, unsigned x, unsigned& nloc, unsigned& nx) {
    const unsigned G = gridDim.x * gridDim.y * gridDim.z;
    unsigned sum, cnt, mine, sp = 0u;
    for (;;) {
        sum = 0u; cnt = 0u; mine = 0u;
#pragma unroll
        for (unsigned j = 0; j < 16; ++j) { const unsigned c = xb_ld(&bar[XB_XCNT(j)]); sum += c; cnt += (c > 0u) ? 1u : 0u; mine = (j == x) ? c : mine; }
        if (sum == G) break;
        __builtin_amdgcn_s_sleep(1);
        if ((++sp & 255u) == 0u) { if (xb_ld(&bar[XB_TMO])) break; if (sp > XB_SPIN_CAP) { atomicAdd(&bar[XB_TMO], 1u); break; } }
    }
    nloc = mine > 0u ? mine : 1u; nx = cnt > 0u ? cnt : 1u;
}

__device__ __forceinline__ void xcd_barrier(const XcdBarrier& b) {
    asm volatile("s_waitcnt vmcnt(0)" ::: "memory");
    __syncthreads();
    if (threadIdx.x == 0) {
        unsigned* bar = b.bar;
        __builtin_amdgcn_s_waitcnt(0);
        unsigned nloc = b.st[0], nx = b.st[1];
        if (nloc == 0u) { xcd_barrier_complete(bar, b.x, nloc, nx); b.st[0] = nloc; b.st[1] = nx; }
        const unsigned old = xb_add(&bar[XB_XSUB(b.x)], 1u);
        const unsigned gen = old / nloc;
        if (old + 1u == (gen + 1u) * nloc) {
            __builtin_amdgcn_fence(__ATOMIC_RELEASE, "agent");
            asm volatile("s_waitcnt vmcnt(0)" ::: "memory");
            const unsigned og = xb_add(&bar[XB_TOP], 1u);
            const unsigned tg = og / nx;
            if (og + 1u == (tg + 1u) * nx) xb_add(&bar[XB_TOPGEN], 1u);
            else XB_SPIN(xb_ld(&bar[XB_TOPGEN]) == tg, bar);
            __builtin_amdgcn_fence(__ATOMIC_ACQUIRE, "agent");
            xb_add(&bar[XB_XGEN(b.x)], 1u);
            asm volatile("s_waitcnt vmcnt(0)" ::: "memory");
        } else {
            XB_SPIN(xb_ld(&bar[XB_XGEN(b.x)]) == gen, bar);
            __builtin_amdgcn_fence(__ATOMIC_ACQUIRE, "agent");
            asm volatile("s_waitcnt vmcnt(0)" ::: "memory");
        }
    }
    __syncthreads();
}


constexpr int NWAVES = 8;
constexpr int NB = 32, SEQ = 2048, T = NB * SEQ, DM = 1024, DEPTH = 4;
constexpr int NPROJ = 3328;
constexpr int NIN = 3088;
constexpr int FF = 2816, FFE = 3584, NE = 8;
constexpr int NMOD = 6 * DM;
constexpr float EPS = 1e-6f;
constexpr int C_CB = 0, C_CC = 256, C_CX = 512, C_SU = 768, C_SV = 1024, C_AQ = 1280, C_AK = 1408, C_AV = 1536, C_AR = 1792, C_HQ = 2048, C_HF = 2304, C_HI = 2560, C_HG = 2816, C_AG = 3072;
constexpr int MOE_ROWS = 2 * T + NE * 256;
constexpr int CH_PAN = 64;
constexpr int N_CHUNK = (MOE_ROWS / 256 + CH_PAN - 1) / CH_PAN;

constexpr size_t MiB = 1u << 20;
constexpr size_t WS_CTL = 0, CTL_ZERO_BYTES = 1 * MiB;
constexpr size_t WS_MOD = 1 * MiB;
constexpr size_t WS_LB = 4 * MiB;
constexpr size_t WS_RE = 5 * MiB;
constexpr size_t WS_RW = 5 * MiB + 512 * 1024;
constexpr size_t WS_RP = 6 * MiB;
constexpr size_t WS_RM = 7 * MiB;
constexpr size_t WS_WIN = 8 * MiB;
constexpr size_t WS_WOUT = 34 * MiB;
constexpr size_t WS_W13D = 42 * MiB;
constexpr size_t WS_W2D = 64 * MiB;
constexpr size_t WS_W13E = 75 * MiB;
constexpr size_t WS_W2E = 299 * MiB;
constexpr size_t WS_H = 411 * MiB;
constexpr size_t WS_MIX = 539 * MiB;
constexpr size_t WS_PROJ = 667 * MiB;
constexpr size_t WS_HID = WS_PROJ;
constexpr size_t WS_YS = WS_MIX;
constexpr size_t WS_HIDC = 799 * MiB;
constexpr size_t WS_END = 1083 * MiB;
static_assert(WS_WIN + (size_t)4 * NPROJ * DM * 2 <= WS_WOUT && WS_W13D + (size_t)2 * 2 * FF * DM * 2 <= WS_W2D && WS_W2D + (size_t)2 * DM * FF * 2 <= WS_W13E, "ws map 1");
static_assert(WS_W13E + (size_t)16 * 2 * FFE * DM * 2 <= WS_W2E && WS_W2E + (size_t)16 * DM * FFE * 2 <= WS_H && WS_H + (size_t)T * DM * 2 <= WS_MIX && WS_MIX + (size_t)T * DM * 2 <= WS_PROJ, "ws map 2");
static_assert(WS_PROJ + (size_t)T * NPROJ * 2 <= WS_END && WS_HID + (size_t)T * FF * 2 <= WS_END && WS_YS + (size_t)MOE_ROWS * DM * 2 <= WS_HIDC && WS_HIDC + (size_t)CH_PAN * 256 * FFE * 2 <= WS_END, "ws map 3");
static_assert(WS_RM + (size_t)MOE_ROWS * 4 <= WS_WIN, "ws map 4");
constexpr int CW_TMO = 0, CW_CODE = 1;
constexpr int CW_BAR = 4096;
constexpr int CW_MOE = 8192;

constexpr int RING_OFF = 0, RING_BYTES = 131072;
constexpr int LDSCTL_OFF = RING_BYTES;
constexpr int ROWTAB_OFF = RING_BYTES + 1024;
constexpr int LDS_BYTES = 147456;
static_assert(ROWTAB_OFF + 8192 <= LDS_BYTES, "LDS map");


typedef float f32x2 __attribute__((ext_vector_type(2)));
typedef unsigned u32x2 __attribute__((ext_vector_type(2)));
typedef int i32x2 __attribute__((ext_vector_type(2)));
#define KARG(i) (*(const float* const volatile __attribute__((address_space(4)))*)((const __attribute__((address_space(4))) char*)__builtin_amdgcn_kernarg_segment_ptr() + 8 * (i)))
struct Frame {
    LAS unsigned char* lds;
    volatile LAS unsigned* MISC;
    gu32* ctl;
    unsigned char* ws;
    float* out;
    int tid, lane, wave, vcu, G;
};
__device__ __forceinline__ float wave_sum(float v) {
#pragma unroll
    for (int o = 1; o < 64; o <<= 1) v += __shfl_xor(v, o);
    return v;
}
__device__ __forceinline__ float bflo(unsigned u) { return __builtin_bit_cast(float, u << 16); }
__device__ __forceinline__ float bfhi(unsigned u) { return __builtin_bit_cast(float, u & 0xffff0000u); }
__device__ __forceinline__ f32x4 ld_bf4(const bf16* p) { const u32x2 u = *(const u32x2*)p; return (f32x4){bflo(u.x), bfhi(u.x), bflo(u.y), bfhi(u.y)}; }
__device__ __forceinline__ void st_bf4(bf16* p, f32x4 v) { u32x2 u; u.x = pg8::cvt_pk_bf16(v[0], v[1]); u.y = pg8::cvt_pk_bf16(v[2], v[3]); *(u32x2*)p = u; }
__device__ __forceinline__ float sigmoid_f(float x) { return __builtin_amdgcn_rcpf(1.0f + __expf(-x)); }
__device__ __forceinline__ float silu_f(float x) { return x * sigmoid_f(x); }
__device__ __forceinline__ float logsigmoid_f(float z) { return fminf(z, 0.f) - __logf(1.0f + __expf(-fabsf(z))); }

__device__ __forceinline__ void p0_item(const float* W, int ldw, int k0, int ns0, bf16* WT, int ldt, int drow0, int nvalid, LAS float* scr, int lane) {
#pragma unroll 8
    for (int i = 0; i < 32; ++i) { const int kk = 2 * i + (lane >> 5); scr[kk * 33 + (lane & 31)] = W[(size_t)(k0 + kk) * ldw + ns0 + (lane & 31)]; }
    LDS_WAIT(); asm volatile("" ::: "memory");
    const int c = lane & 7;
#pragma unroll
    for (int j = 0; j < 4; ++j) { const int n = (lane >> 3) + 8 * j; const LAS float* s = scr + (8 * c) * 33 + n;
        v4u o; o.x = pk2(s[0 * 33], s[1 * 33]); o.y = pk2(s[2 * 33], s[3 * 33]); o.z = pk2(s[4 * 33], s[5 * 33]); o.w = pk2(s[6 * 33], s[7 * 33]);
        if (n >= nvalid) o = (v4u){0u, 0u, 0u, 0u};
        *(GAS v4u*)(WT + (size_t)(drow0 + n) * ldt + k0 + 8 * c) = o; }
    LDS_WAIT(); asm volatile("" ::: "memory");
}
__device__ __forceinline__ int swi_row(int ns0) { return 256 * (ns0 >> 7) + (ns0 & 127); }

__device__ __forceinline__ void p0_prologue(Frame& F) {
    unsigned char* ws = F.ws;
    for (int u = F.vcu; u < 48; u += F.G) {
        LAS float* condT = (LAS float*)(F.lds + RING_OFF);
        const float* cin = KARG(1);
        for (int idx = F.tid; idx < 32768; idx += NWAVES * 64) { const int k = idx >> 5, b = idx & 31; const float cv = cin[b * 1024 + k]; condT[idx] = cv * sigmoid_f(cv); }
        __syncthreads();
        const int l = u / 12, n = (u % 12) * 512 + F.tid;
        float acc[32];
#pragma unroll
        for (int b = 0; b < 32; ++b) acc[b] = 0.f;
        const float* wp = KARG(5) + (size_t)l * 1024 * NMOD + n;
#pragma unroll 4
        for (int k = 0; k < 1024; ++k) { const float w = wp[(size_t)k * NMOD];
#pragma unroll
            for (int b4 = 0; b4 < 8; ++b4) { const f32x4 cv = *(const LAS f32x4*)(condT + k * 32 + 4 * b4);
                acc[4 * b4] += cv[0] * w; acc[4 * b4 + 1] += cv[1] * w; acc[4 * b4 + 2] += cv[2] * w; acc[4 * b4 + 3] += cv[3] * w; } }
        float* mod = (float*)(ws + WS_MOD); const float bb = KARG(6)[l * NMOD + n];
#pragma unroll
        for (int b = 0; b < 32; ++b) mod[(size_t)(l * 32 + b) * NMOD + n] = acc[b] + bb;
        __syncthreads();
    }
    if (F.vcu == F.G - 1 && F.tid < 256) {
        const int c = F.tid; const float* h = KARG(16); float* lb = (float*)(ws + WS_LB);
        const float h0 = h[c], h1 = h[256 + c], h2 = h[512 + c], h3 = h[768 + c], mx = fmaxf(fmaxf(h0, h1), fmaxf(h2, h3));
        const float e0 = __expf(h0 - mx), e1 = __expf(h1 - mx), e2 = __expf(h2 - mx), e3 = __expf(h3 - mx), inv = 1.0f / (e0 + e1 + e2 + e3);
        lb[c] = 0.f; lb[256 + c] = e1 * inv; lb[512 + c] = (e1 + e2) * inv; lb[768 + c] = (e1 + e2 + e3) * inv;
    }
    {   bf16* WIN = (bf16*)(ws + WS_WIN); const int per = 224 * 1024 / 8;
        for (int idx = F.vcu * NWAVES * 64 + F.tid; idx < 4 * per; idx += F.G * NWAVES * 64) { const int l = idx / per, r = idx % per;
            *(GAS v4u*)(WIN + (size_t)l * NPROJ * 1024 + (size_t)3104 * 1024 + (size_t)r * 8) = (v4u){0u, 0u, 0u, 0u}; } }
    LAS float* scr = (LAS float*)(F.lds + RING_OFF + F.wave * 16384);
    const int gw = F.vcu * NWAVES + F.wave, NGW = F.G * NWAVES;
    constexpr int I_IN = 16 * 97, I_OUT = 16 * 32, I_F13 = 16 * 88, I_F2 = 44 * 32, I_E13 = 16 * 112, I_E2 = 56 * 32;
    constexpr int NITEMS = 4 * I_IN + 4 * I_OUT + 4 * I_F13 + 2 * I_F2 + 32 * I_E13 + 16 * I_E2;
    bf16* WIN = (bf16*)(ws + WS_WIN); bf16* WOUT = (bf16*)(ws + WS_WOUT); bf16* W13D = (bf16*)(ws + WS_W13D); bf16* W2D = (bf16*)(ws + WS_W2D); bf16* W13E = (bf16*)(ws + WS_W13E); bf16* W2E = (bf16*)(ws + WS_W2E);
    for (int it = gw; it < NITEMS; it += NGW) {
        int r = it;
        if (r < 4 * I_IN) { const int l = r / I_IN, q = r % I_IN, kb = q / 97, nb = q % 97; const float* W = KARG(7) + (size_t)l * 1024 * NIN; bf16* D = WIN + (size_t)l * NPROJ * 1024;
            if (nb < 96) { const int dc = 32 * nb; p0_item(W, NIN, 64 * kb, dc + (dc >= 1792 ? 16 : 0), D, 1024, dc, 32, scr, F.lane); }
            else p0_item(W, NIN, 64 * kb, 1792, D, 1024, 3072, 16, scr, F.lane);
            continue; }
        r -= 4 * I_IN;
        if (r < 4 * I_OUT) { const int l = r / I_OUT, q = r % I_OUT, kb = q / 32, nb = q % 32; p0_item(KARG(8) + (size_t)l * 1024 * 1024, 1024, 64 * kb, 32 * nb, WOUT + (size_t)l * 1024 * 1024, 1024, 32 * nb, 32, scr, F.lane); continue; }
        r -= 4 * I_OUT;
        if (r < 4 * I_F13) { const int m = r / I_F13, q = r % I_F13, kb = q / 88, nb = q % 88, i = m & 1, up = m >> 1;
            p0_item((up ? KARG(19) : KARG(18)) + (size_t)i * 1024 * FF, FF, 64 * kb, 32 * nb, W13D + (size_t)i * 2 * FF * 1024, 1024, swi_row(32 * nb) + (up ? 128 : 0), 32, scr, F.lane); continue; }
        r -= 4 * I_F13;
        if (r < 2 * I_F2) { const int i = r / I_F2, q = r % I_F2, kb = q / 32, nb = q % 32; p0_item(KARG(20) + (size_t)i * FF * 1024, 1024, 64 * kb, 32 * nb, W2D + (size_t)i * 1024 * FF, FF, 32 * nb, 32, scr, F.lane); continue; }
        r -= 2 * I_F2;
        if (r < 32 * I_E13) { const int m = r / I_E13, q = r % I_E13, kb = q / 112, nb = q % 112, le = m & 15, up = m >> 4;
            p0_item((up ? KARG(23) : KARG(22)) + (size_t)le * 1024 * FFE, FFE, 64 * kb, 32 * nb, W13E + (size_t)le * 2 * FFE * 1024, 1024, swi_row(32 * nb) + (up ? 128 : 0), 32, scr, F.lane); continue; }
        r -= 32 * I_E13;
        { const int le = r / I_E2, q = r % I_E2, kb = q / 32, nb = q % 32; p0_item(KARG(24) + (size_t)le * FFE * 1024, 1024, 64 * kb, 32 * nb, W2E + (size_t)le * 1024 * FFE, FFE, 32 * nb, 32, scr, F.lane); }
    }
}

template <bool COMBINE, bool ROUTER>
__device__ __forceinline__ void norm_phase(Frame& F, const float* xin, float* xout, const float* gain, const float* modl, int sh_off, int sc_off, const float* modprev, const float* router, int moe_idx) {
    unsigned char* ws = F.ws; bf16* H = (bf16*)(ws + WS_H); const bf16* YS = (const bf16*)(ws + WS_YS);
    int* RE = (int*)(ws + WS_RE); f32x2* RW = (f32x2*)(ws + WS_RW); const i32x2* RP = (const i32x2*)(ws + WS_RP);
    LAS float* wr = (LAS float*)(F.lds + RING_OFF);
    LAS unsigned* lcnt = (LAS unsigned*)(F.MISC + 16);
    if (ROUTER) {
        for (int idx = F.tid; idx < 8192; idx += NWAVES * 64) { const int d = idx >> 3, e = idx & 7, j = d >> 8, rem = d & 255, ln = rem >> 2, i = rem & 3; wr[((j * 4 + i) * 64 + ln) * 8 + e] = router[idx]; }
        if (F.tid < 8) lcnt[F.tid] = 0u;
        __syncthreads();
    }
    const int gw = F.vcu * NWAVES + F.wave, NGW = F.G * NWAVES, lane = F.lane;
    for (int m = gw; m < T; m += NGW) {
        const int b = m >> 11;
        const f32x4* xr = (const f32x4*)(xin + (size_t)m * DM);
        f32x4 v[4];
#pragma unroll
        for (int j = 0; j < 4; ++j) v[j] = xr[64 * j + lane];
        if (COMBINE) {
            const i32x2 pp = RP[m]; const f32x2 ww = RW[m];
            const bf16* y0 = YS + (size_t)pp.x * DM; const bf16* y1 = YS + (size_t)pp.y * DM;
            const f32x4* gf = (const f32x4*)(modprev + (size_t)b * NMOD + 5 * DM);
            f32x4* xo = (f32x4*)(xout + (size_t)m * DM);
#pragma unroll
            for (int j = 0; j < 4; ++j) { const f32x4 a = ld_bf4(y0 + 4 * (64 * j + lane)), c = ld_bf4(y1 + 4 * (64 * j + lane)); v[j] = v[j] + gf[64 * j + lane] * (a * ww.x + c * ww.y); xo[64 * j + lane] = v[j]; }
        }
        float ss = 0.f;
#pragma unroll
        for (int j = 0; j < 4; ++j) ss += (v[j][0] * v[j][0] + v[j][1] * v[j][1]) + (v[j][2] * v[j][2] + v[j][3] * v[j][3]);
        const float rstd = rsqrtf(wave_sum(ss) * (1.0f / DM) + EPS);
        const f32x4* g4 = (const f32x4*)gain; const f32x4* sc4 = (const f32x4*)(modl + (size_t)b * NMOD + sc_off); const f32x4* sh4 = (const f32x4*)(modl + (size_t)b * NMOD + sh_off);
        bf16* ho = H + (size_t)m * DM;
#pragma unroll
        for (int j = 0; j < 4; ++j) { v[j] = v[j] * rstd * g4[64 * j + lane] * (sc4[64 * j + lane] + 1.0f) + sh4[64 * j + lane]; st_bf4(ho + 4 * (64 * j + lane), v[j]); }
        if (ROUTER) {
            float lg[8];
#pragma unroll
            for (int e = 0; e < 8; ++e) lg[e] = 0.f;
#pragma unroll
            for (int j = 0; j < 4; ++j)
#pragma unroll
                for (int i = 0; i < 4; ++i) { const LAS float* wp = wr + ((j * 4 + i) * 64 + lane) * 8; const f32x4 w0 = *(const LAS f32x4*)wp, w1 = *(const LAS f32x4*)(wp + 4); const float y = v[j][i];
                    lg[0] += y * w0[0]; lg[1] += y * w0[1]; lg[2] += y * w0[2]; lg[3] += y * w0[3]; lg[4] += y * w1[0]; lg[5] += y * w1[1]; lg[6] += y * w1[2]; lg[7] += y * w1[3]; }
#pragma unroll
            for (int e = 0; e < 8; ++e) lg[e] = wave_sum(lg[e]);
            if (lane == 0) {
                int e0 = 0; float v0 = lg[0];
#pragma unroll
                for (int e = 1; e < 8; ++e) if (lg[e] > v0) { v0 = lg[e]; e0 = e; }
                int e1 = -1; float v1 = -3.0e38f;
#pragma unroll
                for (int e = 0; e < 8; ++e) if (e != e0 && lg[e] > v1) { v1 = lg[e]; e1 = e; }
                const float w0 = 1.0f / (1.0f + __expf(v1 - v0));
                RE[m] = e0 | (e1 << 8); RW[m] = (f32x2){w0, 1.0f - w0};
                __hip_atomic_fetch_add(lcnt + e0, 1u, __ATOMIC_RELAXED, __HIP_MEMORY_SCOPE_WORKGROUP); __hip_atomic_fetch_add(lcnt + e1, 1u, __ATOMIC_RELAXED, __HIP_MEMORY_SCOPE_WORKGROUP);
            }
        }
    }
    if (ROUTER) {
        __syncthreads();
        if (F.tid < 8) __hip_atomic_fetch_add(F.ctl + CW_MOE + moe_idx * 64 + F.tid, lcnt[F.tid], RLX_AGENT);
    }
}
__device__ __forceinline__ void final_phase(Frame& F, const float* modprev) {
    unsigned char* ws = F.ws; const bf16* YS = (const bf16*)(ws + WS_YS); const f32x2* RW = (const f32x2*)(ws + WS_RW); const i32x2* RP = (const i32x2*)(ws + WS_RP);
    const int gw = F.vcu * NWAVES + F.wave, NGW = F.G * NWAVES, lane = F.lane;
    const f32x4* g4 = (const f32x4*)KARG(4);
    for (int m = gw; m < T; m += NGW) {
        const int b = m >> 11;
        f32x4* xr = (f32x4*)(F.out + (size_t)m * DM);
        f32x4 v[4];
#pragma unroll
        for (int j = 0; j < 4; ++j) v[j] = xr[64 * j + lane];
        const i32x2 pp = RP[m]; const f32x2 ww = RW[m];
        const bf16* y0 = YS + (size_t)pp.x * DM; const bf16* y1 = YS + (size_t)pp.y * DM;
        const f32x4* gf = (const f32x4*)(modprev + (size_t)b * NMOD + 5 * DM);
        float ss = 0.f;
#pragma unroll
        for (int j = 0; j < 4; ++j) { const f32x4 a = ld_bf4(y0 + 4 * (64 * j + lane)), c = ld_bf4(y1 + 4 * (64 * j + lane)); v[j] = v[j] + gf[64 * j + lane] * (a * ww.x + c * ww.y);
            ss += (v[j][0] * v[j][0] + v[j][1] * v[j][1]) + (v[j][2] * v[j][2] + v[j][3] * v[j][3]); }
        const float rstd = rsqrtf(wave_sum(ss) * (1.0f / DM) + EPS);
#pragma unroll
        for (int j = 0; j < 4; ++j) xr[64 * j + lane] = v[j] * rstd * g4[64 * j + lane];
    }
}

__device__ __forceinline__ unsigned r256(unsigned x) { return (x + 255u) & ~255u; }
__device__ __forceinline__ void route_phase(Frame& F, int moe_idx) {
    unsigned char* ws = F.ws; const int* RE = (const int*)(ws + WS_RE); i32x2* RP = (i32x2*)(ws + WS_RP); int* RM = (int*)(ws + WS_RM);
    LAS unsigned* lcnt = (LAS unsigned*)(F.MISC + 16); LAS unsigned* lbase = (LAS unsigned*)(F.MISC + 24);
    gu32* gcnt = F.ctl + CW_MOE + moe_idx * 64; gu32* gcur = gcnt + 16;
    unsigned cn[8];
#pragma unroll
    for (int e = 0; e < 8; ++e) cn[e] = __hip_atomic_load(gcnt + e, RLX_AGENT);
    for (int blk = F.vcu; blk < T / 256; blk += F.G) {
        if (F.tid < 8) lcnt[F.tid] = 0u;
        __syncthreads();
        int e0 = 0, e1 = 0; unsigned l0 = 0, l1 = 0; const int tok = blk * 256 + F.tid;
        if (F.tid < 256) { const int ee = RE[tok]; e0 = ee & 255; e1 = ee >> 8;
            l0 = __hip_atomic_fetch_add(lcnt + e0, 1u, __ATOMIC_RELAXED, __HIP_MEMORY_SCOPE_WORKGROUP); l1 = __hip_atomic_fetch_add(lcnt + e1, 1u, __ATOMIC_RELAXED, __HIP_MEMORY_SCOPE_WORKGROUP); }
        __syncthreads();
        if (F.tid < 8) lbase[F.tid] = __hip_atomic_fetch_add(gcur + F.tid, lcnt[F.tid], RLX_AGENT);
        __syncthreads();
        if (F.tid < 256) {
            unsigned o0 = 0, o1 = 0;
#pragma unroll
            for (int j = 0; j < 7; ++j) { o0 += (j < e0) ? r256(cn[j]) : 0u; o1 += (j < e1) ? r256(cn[j]) : 0u; }
            const int p0 = (int)(o0 + lbase[e0] + l0), p1 = (int)(o1 + lbase[e1] + l1);
            RM[p0] = tok; RM[p1] = tok; RP[tok] = (i32x2){p0, p1};
        }
        __syncthreads();
    }
    if (F.vcu < 8) {
        unsigned o = 0;
#pragma unroll
        for (int j = 0; j < 7; ++j) o += (j < F.vcu) ? r256(cn[j]) : 0u;
        unsigned mine = 0;
#pragma unroll
        for (int j = 0; j < 8; ++j) mine = (j == F.vcu) ? cn[j] : mine;
        for (unsigned p = mine + F.tid; p < r256(mine); p += NWAVES * 64) RM[o + p] = 0;
    }
}

__device__ __forceinline__ void conv_phase(Frame& F, int layer) {
    const bf16* PROJ = (const bf16*)(F.ws + WS_PROJ); bf16* MIX = (bf16*)(F.ws + WS_MIX); const float* cw = KARG(9) + layer * 768;
    for (int idx = F.vcu * NWAVES * 64 + F.tid; idx < T * 32; idx += F.G * NWAVES * 64) {
        const int t = idx >> 5, c8 = (idx & 31) * 8, tin = t & (SEQ - 1);
        const bf16* pr = PROJ + (size_t)t * NPROJ;
        float z[3][8];
#pragma unroll
        for (int d = 0; d < 3; ++d) {
            if (tin >= d) { const bf16* q = pr - (size_t)d * NPROJ; const f32x4 a0 = ld_bf4(q + C_CC + c8), a1 = ld_bf4(q + C_CC + c8 + 4), x0 = ld_bf4(q + C_CX + c8), x1 = ld_bf4(q + C_CX + c8 + 4);
#pragma unroll
                for (int i = 0; i < 4; ++i) { z[d][i] = a0[i] * x0[i]; z[d][4 + i] = a1[i] * x1[i]; } }
            else {
#pragma unroll
                for (int i = 0; i < 8; ++i) z[d][i] = 0.f; }
        }
        const f32x4 b0 = ld_bf4(pr + C_CB + c8), b1 = ld_bf4(pr + C_CB + c8 + 4);
        float y[8];
#pragma unroll
        for (int i = 0; i < 8; ++i) { const float bb = i < 4 ? b0[i & 3] : b1[i & 3]; y[i] = bb * (cw[c8 + i] * z[2][i] + cw[256 + c8 + i] * z[1][i] + cw[512 + c8 + i] * z[0][i]); }
        v4u o; o.x = pg8::cvt_pk_bf16(y[0], y[1]); o.y = pg8::cvt_pk_bf16(y[2], y[3]); o.z = pg8::cvt_pk_bf16(y[4], y[5]); o.w = pg8::cvt_pk_bf16(y[6], y[7]);
        *(v4u*)(MIX + (size_t)t * DM + c8) = o;
    }
}

__device__ __forceinline__ void sgu_unit(Frame& F, int layer, int b, int ch) {
    constexpr int LP = 136;
    LAS bf16* vnT = (LAS bf16*)(F.lds + RING_OFF); LAS bf16* Wb = (LAS bf16*)(F.lds + RING_OFF + 256 * LP * 2);
    const bf16* PROJ = (const bf16*)(F.ws + WS_PROJ); bf16* MIX = (bf16*)(F.ws + WS_MIX);
    const size_t row0 = (size_t)b * SEQ + (size_t)ch * 128; const int lane = F.lane, w = F.wave, tid = F.tid;
    const f32x4 gn = *(const f32x4*)(KARG(10) + layer * 256 + 4 * lane);
    __syncthreads();
    for (int s16 = 0; s16 < 16; ++s16) { const int s = w * 16 + s16;
        f32x4 x = ld_bf4(PROJ + (row0 + s) * NPROJ + C_SV + 4 * lane);
        const float mu = wave_sum((x[0] + x[1]) + (x[2] + x[3])) * (1.0f / 256.0f); x = x - mu;
        const float var = wave_sum((x[0] * x[0] + x[1] * x[1]) + (x[2] * x[2] + x[3] * x[3])) * (1.0f / 256.0f); const float rstd = rsqrtf(var + EPS);
#pragma unroll
        for (int i = 0; i < 4; ++i) vnT[(4 * lane + i) * LP + s] = (bf16)f2bf(x[i] * rstd * gn[i]);
    }
    for (int hh = 0; hh < 4; ++hh) {
        __syncthreads();
        {   const int t = tid >> 2, sq = (tid & 3) * 32; const float* wsrc = KARG(11) + ((size_t)(layer * 4 + hh) * 128 + t) * 128 + sq;
#pragma unroll
            for (int c8 = 0; c8 < 4; ++c8) { const f32x4 a = *(const f32x4*)(wsrc + 8 * c8), c = *(const f32x4*)(wsrc + 8 * c8 + 4); float f[8] = {a[0], a[1], a[2], a[3], c[0], c[1], c[2], c[3]};
#pragma unroll
                for (int i = 0; i < 8; ++i) if (sq + 8 * c8 + i > t) f[i] = 0.f;
                v4u o; o.x = pk2(f[0], f[1]); o.y = pk2(f[2], f[3]); o.z = pk2(f[4], f[5]); o.w = pk2(f[6], f[7]);
                *(LAS v4u*)(Wb + t * LP + sq + 8 * c8) = o; } }
        __syncthreads();
        f32x4 acc[4];
#pragma unroll
        for (int nt = 0; nt < 4; ++nt) acc[nt] = (f32x4){0.f, 0.f, 0.f, 0.f};
        for (int ks = 0; ks < 4; ++ks) { if (32 * ks > 16 * w + 15) break;
            const bf16x8 a = *(const LAS bf16x8*)(Wb + (16 * w + (lane & 15)) * LP + 32 * ks + 8 * (lane >> 4));
#pragma unroll
            for (int nt = 0; nt < 4; ++nt) { const bf16x8 bb = *(const LAS bf16x8*)(vnT + (hh * 64 + 16 * nt + (lane & 15)) * LP + 32 * ks + 8 * (lane >> 4));
                acc[nt] = __builtin_amdgcn_mfma_f32_16x16x32_bf16(a, bb, acc[nt], 0, 0, 0); } }
        const float* sb = KARG(12) + (size_t)(layer * 4 + hh) * 128;
#pragma unroll
        for (int nt = 0; nt < 4; ++nt)
#pragma unroll
            for (int r = 0; r < 4; ++r) { const int tl = 16 * w + 4 * (lane >> 4) + r, c = hh * 64 + 16 * nt + (lane & 15);
                const float su = bflo((unsigned)PROJ[(row0 + tl) * NPROJ + C_SU + c]);
                MIX[(row0 + tl) * DM + 256 + c] = (bf16)f2bf(su * (acc[nt][r] + sb[tl])); }
    }
}

template <bool GLA>
__device__ __forceinline__ void recur_unit(Frame& F, int layer, int b, int hh) {
    constexpr int KD = GLA ? 32 : 64, R = KD / 8;
    LAS float* sA = (LAS float*)(F.lds + RING_OFF); LAS float* sK = sA + 2048; LAS float* sQ = sK + 2048; LAS float* sV = sQ + 2048; LAS float* sPO = sV + 2048;
    const bf16* PROJ = (const bf16*)(F.ws + WS_PROJ); bf16* MIX = (bf16*)(F.ws + WS_MIX); const float* LB = (const float*)(F.ws + WS_LB);
    const int tid = F.tid, lane = F.lane, w = F.wave, ptok = tid >> 4, pc4 = (tid & 15) * 4, pk2i = (tid & 15) * 2;
    float S[R];
#pragma unroll
    for (int j = 0; j < R; ++j) S[j] = 0.f;
    const f32x4 ngv = *(const f32x4*)((GLA ? KARG(15) : KARG(17)) + layer * 64 + pc4);
    f32x4 lbv = (f32x4){0.f, 0.f, 0.f, 0.f}; float wg0[16], wg1[16], bg0 = 0.f, bg1 = 0.f;
    if (!GLA) lbv = *(const f32x4*)(LB + layer * 256 + hh * 64 + pc4);
    else {
#pragma unroll
        for (int r = 0; r < 16; ++r) { wg0[r] = KARG(13)[(size_t)layer * 2048 + r * 128 + hh * 32 + pk2i]; wg1[r] = KARG(13)[(size_t)layer * 2048 + r * 128 + hh * 32 + pk2i + 1]; }
        bg0 = KARG(14)[layer * 128 + hh * 32 + pk2i]; bg1 = KARG(14)[layer * 128 + hh * 32 + pk2i + 1];
    }
    __syncthreads();
    for (int t0 = 0; t0 < SEQ; t0 += 32) {
        const size_t row = (size_t)b * SEQ + t0 + ptok; const bf16* pr = PROJ + row * NPROJ;
        if (!GLA) {
            const f32x4 q = ld_bf4(pr + C_HQ + hh * 64 + pc4), fl = ld_bf4(pr + C_HF + hh * 64 + pc4), iv = ld_bf4(pr + C_HI + hh * 64 + pc4);
            f32x4 f;
#pragma unroll
            for (int i = 0; i < 4; ++i) f[i] = lbv[i] + (1.0f - lbv[i]) * sigmoid_f(fl[i]);
            *(LAS f32x4*)(sA + ptok * 64 + pc4) = f; *(LAS f32x4*)(sK + ptok * 64 + pc4) = 1.0f - f; *(LAS f32x4*)(sQ + ptok * 64 + pc4) = q; *(LAS f32x4*)(sV + ptok * 64 + pc4) = iv;
        } else {
            *(LAS f32x4*)(sV + ptok * 64 + pc4) = ld_bf4(pr + C_AV + hh * 64 + pc4);
            const unsigned uq = *(const unsigned*)(pr + C_AQ + hh * 32 + pk2i), uk = *(const unsigned*)(pr + C_AK + hh * 32 + pk2i);
            const v4u g0 = *(const v4u*)(pr + C_AG), g1 = *(const v4u*)(pr + C_AG + 8);
            const float ag[16] = {bflo(g0.x), bfhi(g0.x), bflo(g0.y), bfhi(g0.y), bflo(g0.z), bfhi(g0.z), bflo(g0.w), bfhi(g0.w), bflo(g1.x), bfhi(g1.x), bflo(g1.y), bfhi(g1.y), bflo(g1.z), bfhi(g1.z), bflo(g1.w), bfhi(g1.w)};
            float z0 = bg0, z1 = bg1;
#pragma unroll
            for (int r = 0; r < 16; ++r) { z0 += ag[r] * wg0[r]; z1 += ag[r] * wg1[r]; }
            *(LAS f32x2*)(sA + ptok * 64 + pk2i) = (f32x2){__expf(logsigmoid_f(z0) * 0.0625f), __expf(logsigmoid_f(z1) * 0.0625f)};
            *(LAS f32x2*)(sK + ptok * 64 + pk2i) = (f32x2){bflo(uk), bfhi(uk)};
            *(LAS f32x2*)(sQ + ptok * 64 + pk2i) = (f32x2){bflo(uq) * 0.17677669529663687f, bfhi(uq) * 0.17677669529663687f};
        }
        __syncthreads();
#pragma unroll 2
        for (int tt = 0; tt < 32; ++tt) {
            const float v = sV[tt * 64 + lane]; float o = 0.f;
#pragma unroll
            for (int j4 = 0; j4 < R / 4; ++j4) { const f32x4 a = *(const LAS f32x4*)(sA + tt * 64 + R * w + 4 * j4), kk = *(const LAS f32x4*)(sK + tt * 64 + R * w + 4 * j4), q = *(const LAS f32x4*)(sQ + tt * 64 + R * w + 4 * j4);
#pragma unroll
                for (int i = 0; i < 4; ++i) { S[4 * j4 + i] = a[i] * S[4 * j4 + i] + kk[i] * v; o += q[i] * S[4 * j4 + i]; } }
            sPO[(w * 32 + tt) * 64 + lane] = o;
        }
        __syncthreads();
        f32x4 o4 = (f32x4){0.f, 0.f, 0.f, 0.f};
#pragma unroll
        for (int ww = 0; ww < 8; ++ww) o4 = o4 + *(const LAS f32x4*)(sPO + (ww * 32 + ptok) * 64 + pc4);
        float ss = (o4[0] * o4[0] + o4[1] * o4[1]) + (o4[2] * o4[2] + o4[3] * o4[3]);
        ss += __shfl_xor(ss, 1); ss += __shfl_xor(ss, 2); ss += __shfl_xor(ss, 4); ss += __shfl_xor(ss, 8);
        const float rstd = rsqrtf(ss * (1.0f / 64.0f) + EPS);
        const f32x4 gt = ld_bf4(pr + (GLA ? C_AR : C_HG) + hh * 64 + pc4);
        f32x4 y;
#pragma unroll
        for (int i = 0; i < 4; ++i) y[i] = o4[i] * rstd * ngv[i] * silu_f(gt[i]);
        st_bf4(MIX + row * DM + (GLA ? 512 : 768) + hh * 64 + pc4, y);
    }
    __syncthreads();
}
__device__ __forceinline__ void mixer_phase(Frame& F, int layer) {
    for (int u = F.vcu; u < 256; u += F.G) { const int bh = u >> 1, b = bh >> 2, hh = bh & 3; if (u & 1) recur_unit<true>(F, layer, b, hh); else recur_unit<false>(F, layer, b, hh); }
    for (int u = F.vcu; u < NB * 16; u += F.G) sgu_unit(F, layer, u >> 4, u & 15);
    conv_phase(F, layer);
}


#define EN_ID(x) x
#define EN_NO(x) ((void)0)
#ifdef DIS_P0
#define EN_P0(x) ((void)0)
#else
#define EN_P0(x) x
#endif
#ifdef DIS_NORM
#define EN_NORM(x) ((void)0)
#else
#define EN_NORM(x) x
#endif
#ifdef DIS_MX
#define EN_MX(x) ((void)0)
#else
#define EN_MX(x) x
#endif
#ifdef DIS_FINAL
#define EN_FINAL(x) ((void)0)
#else
#define EN_FINAL(x) x
#endif
#ifdef DIS_G1
#define EN_G1(x) ((void)0)
#else
#define EN_G1(x) x
#endif
#ifdef DIS_G2
#define EN_G2(x) ((void)0)
#else
#define EN_G2(x) x
#endif
#ifdef DIS_G3
#define EN_G3(x) ((void)0)
#else
#define EN_G3(x) x
#endif
#ifdef DIS_G4
#define EN_G4(x) ((void)0)
#else
#define EN_G4(x) x
#endif
#ifdef DIS_UP
#define EN_UP(x) ((void)0)
#else
#define EN_UP(x) x
#endif
#ifdef DIS_DN
#define EN_DN(x) ((void)0)
#else
#define EN_DN(x) x
#endif
constexpr int N_STEPS = 1 + 4 * 5 + 2 * 2 + 2 * (1 + 2 * N_CHUNK) + 1;
struct Args { const float* in[25]; float* out; unsigned char* ws; int lo, hi; };
__global__ void __launch_bounds__(NWAVES * 64, 2) fwd_kernel(Args args) {
    extern __shared__ __attribute__((aligned(16))) unsigned char lds[];
    Frame F;
    F.lds = (LAS unsigned char*)lds; F.MISC = (volatile LAS unsigned*)(F.lds + LDSCTL_OFF);
    F.tid = threadIdx.x; F.lane = F.tid & 63; F.wave = __builtin_amdgcn_readfirstlane(F.tid >> 6);
    F.G = gridDim.x; { const int bx = blockIdx.x; F.vcu = (F.G % 8 == 0) ? (bx % 8) * (F.G / 8) + bx / 8 : bx; }
    F.ws = args.ws; F.ctl = (gu32*)(args.ws + WS_CTL); F.out = args.out;
    for (int u = F.tid; u < 256; u += NWAVES * 64) ((LAS unsigned*)(F.lds + LDSCTL_OFF))[u] = 0u;
    __syncthreads();
    const int lo = args.lo, hi = args.hi;
    XcdBarrier bar; bar.bar = (unsigned*)(F.ctl + CW_BAR); bar.x = 0; bar.st = nullptr;
    if (hi - lo > 1) bar = xcd_barrier_post((unsigned*)(F.ctl + CW_BAR), F.MISC + 8);
    int step = 0;
#define RUN_STEP(body) do { if (step >= lo && step < hi) { asm volatile("" : "+v"(F.tid)); asm volatile("" : "+v"(F.lane)); asm volatile("" : "+s"(F.wave)); asm volatile("" : "+s"(F.vcu));   body; if (step + 1 < hi) xcd_barrier(bar); } ++step; } while (0)
    LAS unsigned char* ring = F.lds + RING_OFF; LAS int* rowtab = (LAS int*)(F.lds + ROWTAB_OFF);
    unsigned char* ws = F.ws;
    const pg8::bf16_t* H = (const pg8::bf16_t*)(ws + WS_H); const pg8::bf16_t* MIXB = (const pg8::bf16_t*)(ws + WS_MIX);
    const float* MOD = (const float*)(ws + WS_MOD);

    RUN_STEP(EN_P0(p0_prologue(F)));
    for (int l = 0; l < DEPTH; ++l) {
        const float* modl = MOD + (size_t)l * 32 * NMOD; const float* modp = MOD + (size_t)(l > 0 ? l - 1 : 0) * 32 * NMOD;
        const float* xcur = (l == 0) ? KARG(0) : F.out;
        if (l == 2) RUN_STEP(EN_NORM((norm_phase<true, false>(F, xcur, F.out, KARG(2) + l * DM, modl, 0, DM, modp, nullptr, 0))));
        else        RUN_STEP(EN_NORM((norm_phase<false, false>(F, xcur, nullptr, KARG(2) + l * DM, modl, 0, DM, nullptr, nullptr, 0))));
        RUN_STEP(({ pg8::Gemm g{H, (const pg8::bf16_t*)(ws + WS_WIN) + (size_t)l * NPROJ * DM, DM}; pg8::StaticOrder S; S.init(T, NPROJ, F.G, (int)blockIdx.x);
                    pg8::EpiBf16 E{(pg8::bf16_t*)(ws + WS_PROJ), NPROJ}; EN_G1((pg8::gemm_phase<pg8::EpiBf16, pg8::StaticOrder, true>(ring, rowtab, g, S, E))); }));
        RUN_STEP(EN_MX(mixer_phase(F, l)));
        RUN_STEP(({ pg8::Gemm g{MIXB, (const pg8::bf16_t*)(ws + WS_WOUT) + (size_t)l * DM * DM, DM}; pg8::StaticOrder S; S.init(T, DM, F.G, (int)blockIdx.x);
                    pg8::EpiRes E{xcur, F.out, modl + 2 * DM, NMOD}; EN_G2((pg8::gemm_phase<pg8::EpiRes, pg8::StaticOrder, true>(ring, rowtab, g, S, E))); }));
        if ((l & 1) == 0) {
            const int i = l >> 1;
            RUN_STEP(EN_NORM((norm_phase<false, false>(F, F.out, nullptr, KARG(3) + l * DM, modl, 3 * DM, 4 * DM, nullptr, nullptr, 0))));
            RUN_STEP(({ pg8::Gemm g{H, (const pg8::bf16_t*)(ws + WS_W13D) + (size_t)i * 2 * FF * DM, DM}; pg8::StaticOrder S; S.init(T, 2 * FF, F.G, (int)blockIdx.x);
                        pg8::EpiSwiglu E{(pg8::bf16_t*)(ws + WS_HID), FF}; EN_G3((pg8::gemm_phase<pg8::EpiSwiglu, pg8::StaticOrder, true>(ring, rowtab, g, S, E))); }));
            RUN_STEP(({ pg8::Gemm g{(const pg8::bf16_t*)(ws + WS_HID), (const pg8::bf16_t*)(ws + WS_W2D) + (size_t)i * DM * FF, FF}; pg8::StaticOrder S; S.init(T, DM, F.G, (int)blockIdx.x);
                        pg8::EpiRes E{F.out, F.out, modl + 5 * DM, NMOD}; EN_G4((pg8::gemm_phase<pg8::EpiRes, pg8::StaticOrder, true>(ring, rowtab, g, S, E))); }));
        } else {
            const int i = l >> 1;
            RUN_STEP(EN_NORM((norm_phase<false, true>(F, F.out, nullptr, KARG(3) + l * DM, modl, 3 * DM, 4 * DM, nullptr, KARG(21) + (size_t)i * DM * NE, i))));
            RUN_STEP(EN_NORM(route_phase(F, i)));
            for (int c = 0; c < N_CHUNK; ++c) {
                int ps[9]; ps[0] = 0;
                if (step + 1 >= lo && step < hi) {
#pragma unroll
                    for (int e = 0; e < 8; ++e) ps[e + 1] = ps[e] + (int)((__hip_atomic_load(F.ctl + CW_MOE + i * 64 + e, RLX_AGENT) + 255u) >> 8);
                } else {
#pragma unroll
                    for (int e = 0; e < 8; ++e) ps[e + 1] = 0;
                }
                const int pan0 = c * CH_PAN; int npan = ps[8] - pan0; npan = npan < 0 ? 0 : (npan > CH_PAN ? CH_PAN : npan);
                RUN_STEP(({ pg8::Gemm g{H, (const pg8::bf16_t*)(ws + WS_W13E) + (size_t)i * 8 * 2 * FFE * DM, DM};
                            pg8::MoeOrder<true> S; S.so.init(npan * 256, 2 * FFE, F.G, (int)blockIdx.x); S.pan0 = pan0; S.ps1 = ps[1]; S.ps2 = ps[2]; S.ps3 = ps[3]; S.ps4 = ps[4]; S.ps5 = ps[5]; S.ps6 = ps[6]; S.ps7 = ps[7];
                            S.estride = (size_t)2 * FFE * DM * 2; S.rowmap = (const int*)(ws + WS_RM);
                            pg8::EpiSwiglu E{(pg8::bf16_t*)(ws + WS_HIDC), FFE}; EN_UP((pg8::gemm_phase<pg8::EpiSwiglu, pg8::MoeOrder<true>, true>(ring, rowtab, g, S, E))); }));
                RUN_STEP(({ pg8::Gemm g{(const pg8::bf16_t*)(ws + WS_HIDC), (const pg8::bf16_t*)(ws + WS_W2E) + (size_t)i * 8 * DM * FFE, FFE};
                            pg8::MoeOrder<false> S; S.so.init(npan * 256, DM, F.G, (int)blockIdx.x); S.pan0 = pan0; S.ps1 = ps[1]; S.ps2 = ps[2]; S.ps3 = ps[3]; S.ps4 = ps[4]; S.ps5 = ps[5]; S.ps6 = ps[6]; S.ps7 = ps[7];
                            S.estride = (size_t)DM * FFE * 2; S.rowmap = nullptr;
                            pg8::EpiBf16 E{(pg8::bf16_t*)(ws + WS_YS) + (size_t)pan0 * 256 * DM, DM}; EN_DN((pg8::gemm_phase<pg8::EpiBf16, pg8::MoeOrder<false>, true>(ring, rowtab, g, S, E))); }));
            }
        }
    }
    RUN_STEP(EN_FINAL(final_phase(F, MOD + (size_t)3 * 32 * NMOD)));
#undef RUN_STEP
}

#ifndef N_LAUNCH_MODE
#define N_LAUNCH_MODE 0
#endif
extern "C" void kernel_launch(void* const* d_in, const int* in_sizes, int n_in, void* d_out, int out_size, void* d_ws, size_t ws_size, hipStream_t stream) {
    static int grid = 0;
    if (grid == 0) {
        if (n_in != 25 || in_sizes[0] != T * DM || out_size != T * DM || ws_size < WS_END) { fprintf(stderr, "kernel_launch: unexpected shapes (n_in %d, in0 %d, out %d, ws %zu < %zu); nothing launched\n", n_in, n_in > 0 ? in_sizes[0] : -1, out_size, ws_size, (size_t)WS_END); grid = -1; return; }
        int dev = 0, cus = 0, per_cu = 0;
        if (hipGetDevice(&dev) != hipSuccess || hipDeviceGetAttribute(&cus, hipDeviceAttributeMultiprocessorCount, dev) != hipSuccess) { grid = -1; return; }
        if (hipFuncSetAttribute((const void*)fwd_kernel, hipFuncAttributeMaxDynamicSharedMemorySize, LDS_BYTES) != hipSuccess) { fprintf(stderr, "kernel_launch: hipFuncSetAttribute failed\n"); grid = -1; return; }
        if (hipOccupancyMaxActiveBlocksPerMultiprocessor(&per_cu, (const void*)fwd_kernel, NWAVES * 64, LDS_BYTES) != hipSuccess || per_cu < 1) fprintf(stderr, "kernel_launch: occupancy query says %d\n", per_cu);
        (void)hipGetLastError();
        grid = cus;
        if (grid != 256) fprintf(stderr, "kernel_launch: %d CUs (built for 256)\n", grid);
    }
    if (grid < 0) return;
    if (hipMemsetAsync((char*)d_ws + WS_CTL, 0, CTL_ZERO_BYTES, stream) != hipSuccess) return;
    Args a{};
    for (int i = 0; i < 25; ++i) a.in[i] = (const float*)d_in[i];
    a.out = (float*)d_out; a.ws = (unsigned char*)d_ws;
#if N_LAUNCH_MODE == 1
    a.lo = 0; a.hi = N_STEPS;
    hipLaunchKernelGGL(fwd_kernel, dim3(grid), dim3(NWAVES * 64), LDS_BYTES, stream, a);
#else
    for (int s = 0; s < N_STEPS; ++s) { a.lo = s; a.hi = s + 1; hipLaunchKernelGGL(fwd_kernel, dim3(grid), dim3(NWAVES * 64), LDS_BYTES, stream, a); }
#endif
}
```

```cpp
#include <hip/hip_runtime.h>
#include <cstdio>
#include <cstdint>

namespace pg8 {
#define PG8_LAS __attribute__((address_space(3)))
typedef unsigned short bf16_t;
typedef short bf16x8 __attribute__((ext_vector_type(8)));
typedef float f32x4 __attribute__((ext_vector_type(4)));
typedef unsigned u32x4 __attribute__((ext_vector_type(4)));
constexpr int BM = 256, BK = 64, HALF = 128, HTB = HALF * BK * 2  , STAGE_BYTES = 8 * HTB, NXCD = 8, WGM = 8;

__host__ __device__ __forceinline__ int lds_byte(int r, int c) { const int st = (r >> 4) * 2 + (c >> 5), rr = r & 15, cc = c & 31, ob = rr * 64 + cc * 2; return st * 1024 + (ob ^ (((ob >> 9) & 1) << 5)); }
__host__ __device__ __forceinline__ void stage_rc(int b, int& R, int& C) { const int st = b / 1024, sb = b % 1024, swz = sb ^ (((sb >> 9) & 1) << 5); R = (st >> 1) * 16 + swz / 64; C = (st & 1) * 32 + (swz % 64) / 2; }
__host__ __device__ __forceinline__ int perm32(int rho) { const int n = rho >> 4, i = rho & 15; return 8 * (i >> 2) + 4 * n + (i & 3); }

template <bool C, class A, class B> struct SelT { typedef A type; }; template <class A, class B> struct SelT<false, A, B> { typedef B type; };
struct Unit { int pm, pn; };
struct Gemm { const bf16_t* A; const bf16_t* Bt; int K; };

struct StaticOrder {
    static constexpr bool GATHER = false;
    int nM, nN, nwg, G, c, rev, nh, hq;
    __host__ __device__ void init(int M, int N, int G_, int c_, int rev_ = 0, int nh_ = 0, int hq_ = 4) { nM = M / BM; nN = N / BM; nwg = nM * nN; G = G_; c = c_; rev = rev_; nh = nh_; hq = hq_; }
    __host__ __device__ bool next(int i, Unit& u) const {
        long L = (long)i * G + c;
        if (nh) { const int nl = G - nh, v = c >= nh ? c - nh : c + nl; if (i < hq) L = (long)i * G + v; else { if (v >= nl) return false; L = (long)hq * G + (long)(i - hq) * nl + v; } }
        if (L >= nwg) return false;
        int wgid = rev ? (nwg - 1 - (int)L) : (int)L; { const int q = nwg / NXCD, r = nwg % NXCD, xcd = wgid % NXCD, off = wgid / NXCD; wgid = (xcd < r ? xcd * (q + 1) : r * (q + 1) + (xcd - r) * q) + off; }
        const int nig = WGM * nN, gid = wgid / nig, fm = gid * WGM, gsz = (nM - fm) < WGM ? (nM - fm) : WGM;
        u.pm = fm + ((wgid % nig) % gsz); u.pn = (wgid % nig) / gsz; return true;
    }
    __device__ __forceinline__ const char* a_base(const Gemm& g, const Unit& u) const { return (const char*)g.A + (unsigned)u.pm * (unsigned)(BM * g.K * 2); }
    __device__ __forceinline__ const char* b_base(const Gemm& g, const Unit& u) const { return (const char*)g.Bt + (unsigned)u.pn * (unsigned)(BM * g.K * 2); }
    __device__ __forceinline__ int row_index(const Unit&, int) const { return 0; }
};

template <bool GATH> struct MoeOrder {
    static constexpr bool GATHER = GATH;
    StaticOrder so; int pan0; int ps1, ps2, ps3, ps4, ps5, ps6, ps7; size_t estride  ; const int* rowmap;
    __device__ __forceinline__ bool next(int i, Unit& u) const { return so.next(i, u); }
    __device__ __forceinline__ int expert_of(int p) const { return (p >= ps1) + (p >= ps2) + (p >= ps3) + (p >= ps4) + (p >= ps5) + (p >= ps6) + (p >= ps7); }
    __device__ __forceinline__ const char* a_base(const Gemm& g, const Unit& u) const { return GATH ? (const char*)g.A : (const char*)g.A + (unsigned)u.pm * (unsigned)(BM * g.K * 2); }
    __device__ __forceinline__ const char* b_base(const Gemm& g, const Unit& u) const { return (const char*)g.Bt + ((unsigned)expert_of(pan0 + u.pm) * (unsigned)estride + (unsigned)u.pn * (unsigned)(BM * g.K * 2)); }
    __device__ __forceinline__ int row_index(const Unit& u, int r) const { return rowmap[(size_t)(pan0 + u.pm) * BM + r]; }
};

typedef float f32x2_t __attribute__((ext_vector_type(2))); typedef __bf16 bf16x2_t __attribute__((ext_vector_type(2)));
__device__ __forceinline__ unsigned cvt_pk_bf16(float lo, float hi) { const f32x2_t v = {lo, hi}; const bf16x2_t b = __builtin_convertvector(v, bf16x2_t); return __builtin_bit_cast(unsigned, b); }
__device__ __forceinline__ float silu_f(float x) { return x * __builtin_amdgcn_rcpf(1.0f + __expf(-x)); }
__device__ __forceinline__ f32x2_t swiglu2(f32x2_t g, f32x2_t u) { const f32x2_t t = g * u; f32x2_t e; e.x = __builtin_amdgcn_exp2f(-g.x); e.y = __builtin_amdgcn_exp2f(-g.y); const f32x2_t d = e + 1.0f; f32x2_t r; r.x = __builtin_amdgcn_rcpf(d.x); r.y = __builtin_amdgcn_rcpf(d.y); return t * r; }
typedef int i32x4_t __attribute__((ext_vector_type(4))); typedef int i32x8_t __attribute__((ext_vector_type(8))); typedef unsigned u32x2_t __attribute__((ext_vector_type(2)));
__device__ __forceinline__ unsigned cvt_pk4_fp8(float a, float b, float c, float d) {
    a = __builtin_amdgcn_fmed3f(a, -448.f, 448.f); b = __builtin_amdgcn_fmed3f(b, -448.f, 448.f); c = __builtin_amdgcn_fmed3f(c, -448.f, 448.f); d = __builtin_amdgcn_fmed3f(d, -448.f, 448.f);
    int p = __builtin_amdgcn_cvt_pk_fp8_f32(a, b, 0, false); p = __builtin_amdgcn_cvt_pk_fp8_f32(c, d, p, true); return (unsigned)p; }
constexpr float W13_8_SCALE = 16.0f;
constexpr float W2_8_SCALE = 512.0f;

struct EpiBf16 {
    static constexpr bool PERM = true;
    bf16_t* O; int ldc;
    __device__ __forceinline__ void operator()(const f32x4 (&acc)[2][2][4][2], const Unit& u, int wr, int wc, int fr, int fq) const {
        asm volatile("" : "+v"(fr)); asm volatile("" : "+v"(fq));
        const int row0 = u.pm * BM + wr * 64 + fr, col0 = u.pn * BM + wc * 32 + 8 * fq;
#pragma unroll
        for (int ai = 0; ai < 2; ++ai)
#pragma unroll
            for (int m = 0; m < 4; ++m) { bf16_t* rowp = O + (size_t)(row0 + ai * HALF + m * 16) * ldc + col0;
#pragma unroll
                for (int bj = 0; bj < 2; ++bj) { const f32x4 v0 = acc[ai][bj][m][0], v1 = acc[ai][bj][m][1];
                    u32x4 w; w.x = cvt_pk_bf16(v0[0], v0[1]); w.y = cvt_pk_bf16(v0[2], v0[3]); w.z = cvt_pk_bf16(v1[0], v1[1]); w.w = cvt_pk_bf16(v1[2], v1[3]);
                    *(u32x4*)(rowp + bj * HALF) = w; } }
    }
};
struct EpiSwiglu {
    static constexpr bool PERM = true;
    bf16_t* O; int ldc;
    __device__ __forceinline__ void operator()(const f32x4 (&acc)[2][2][4][2], const Unit& u, int wr, int wc, int fr, int fq) const {
        asm volatile("" : "+v"(fr)); asm volatile("" : "+v"(fq));
        const int row0 = u.pm * BM + wr * 64 + fr, col0 = u.pn * HALF + wc * 32 + 8 * fq;
#pragma unroll
        for (int ai = 0; ai < 2; ++ai)
#pragma unroll
            for (int m = 0; m < 4; ++m) { bf16_t* rowp = O + (size_t)(row0 + ai * HALF + m * 16) * ldc + col0;
                const f32x4 g0 = acc[ai][0][m][0], g1 = acc[ai][0][m][1], u0 = acc[ai][1][m][0], u1 = acc[ai][1][m][1];
                float h[8];
#pragma unroll
                for (int i = 0; i < 4; i += 2) { const f32x2_t ha = swiglu2((f32x2_t){g0[i], g0[i + 1]}, (f32x2_t){u0[i], u0[i + 1]}), hb = swiglu2((f32x2_t){g1[i], g1[i + 1]}, (f32x2_t){u1[i], u1[i + 1]});
                    h[i] = ha.x; h[i + 1] = ha.y; h[4 + i] = hb.x; h[5 + i] = hb.y; }
                u32x4 w; w.x = cvt_pk_bf16(h[0], h[1]); w.y = cvt_pk_bf16(h[2], h[3]); w.z = cvt_pk_bf16(h[4], h[5]); w.w = cvt_pk_bf16(h[6], h[7]);
                *(u32x4*)rowp = w; }
    }
};
struct EpiSwiglu8 {
    static constexpr bool PERM = true;
    unsigned char* O; int ldc;
    __device__ __forceinline__ void operator()(const f32x4 (&acc)[2][2][4][2], const Unit& u, int wr, int wc, int fr, int fq) const {
        asm volatile("" : "+v"(fr)); asm volatile("" : "+v"(fq));
        const int row0 = u.pm * BM + wr * 64 + fr, col0 = u.pn * HALF + wc * 32 + 8 * fq;
#pragma unroll
        for (int ai = 0; ai < 2; ++ai)
#pragma unroll
            for (int m = 0; m < 4; ++m) { unsigned char* rowp = O + (size_t)(row0 + ai * HALF + m * 16) * ldc + col0;
                const f32x4 g0 = acc[ai][0][m][0], g1 = acc[ai][0][m][1], u0 = acc[ai][1][m][0], u1 = acc[ai][1][m][1];
                float h[8];
#pragma unroll
                for (int i = 0; i < 4; i += 2) { const f32x2_t ha = swiglu2((f32x2_t){g0[i], g0[i + 1]}, (f32x2_t){u0[i], u0[i + 1]}), hb = swiglu2((f32x2_t){g1[i], g1[i + 1]}, (f32x2_t){u1[i], u1[i + 1]});
                    h[i] = ha.x; h[i + 1] = ha.y; h[4 + i] = hb.x; h[5 + i] = hb.y; }
                u32x2_t w; w.x = cvt_pk4_fp8(h[0], h[1], h[2], h[3]); w.y = cvt_pk4_fp8(h[4], h[5], h[6], h[7]);
                *(u32x2_t*)rowp = w; }
    }
};
struct EpiRes {
    static constexpr bool PERM = false;
    const float* xin; float* xout; const float* gate; int gstride;
    __device__ __forceinline__ void operator()(const f32x4 (&acc)[2][2][4][2], const Unit& u, int wr, int wc, int fr, int fq) const {
        asm volatile("" : "+v"(fr)); asm volatile("" : "+v"(fq));
        const int row0 = u.pm * BM + wr * 64 + fr, col0 = u.pn * BM + wc * 32 + 4 * fq;
        const float* gp = gate + (size_t)(u.pm >> 3) * gstride + col0;
        f32x4 gv[2][2];
#pragma unroll
        for (int bj = 0; bj < 2; ++bj)
#pragma unroll
            for (int n = 0; n < 2; ++n) gv[bj][n] = *(const f32x4*)(gp + bj * HALF + n * 16);
#pragma unroll
        for (int ai = 0; ai < 2; ++ai) {
            f32x4 xi[4][2][2];
#pragma unroll
            for (int m = 0; m < 4; ++m) { const size_t off = (size_t)(row0 + ai * HALF + m * 16) * 1024 + col0;
#pragma unroll
                for (int bj = 0; bj < 2; ++bj)
#pragma unroll
                    for (int n = 0; n < 2; ++n) xi[m][bj][n] = *(const f32x4*)(xin + off + bj * HALF + n * 16); }
            asm volatile("" ::: "memory");
#pragma unroll
            for (int m = 0; m < 4; ++m) { const size_t off = (size_t)(row0 + ai * HALF + m * 16) * 1024 + col0;
#pragma unroll
                for (int bj = 0; bj < 2; ++bj)
#pragma unroll
                    for (int n = 0; n < 2; ++n) *(f32x4*)(xout + off + bj * HALF + n * 16) = xi[m][bj][n] + gv[bj][n] * acc[ai][bj][m][n]; }
            asm volatile("" ::: "memory");
        }
    }
};

struct EpiResB {
    static constexpr bool PERM = true;
    const bf16_t* xin; bf16_t* xout; const float* gate; int gstride; float gs;
    __device__ __forceinline__ void operator()(const f32x4 (&acc)[2][2][4][2], const Unit& u, int wr, int wc, int fr, int fq) const {
        asm volatile("" : "+v"(fr)); asm volatile("" : "+v"(fq));
        const int row0 = u.pm * BM + wr * 64 + fr, col0 = u.pn * BM + wc * 32 + 8 * fq;
        const float* gp = gate + (size_t)(u.pm >> 3) * gstride + col0;
        f32x4 gv[2][2];
#pragma unroll
        for (int bj = 0; bj < 2; ++bj)
#pragma unroll
            for (int n = 0; n < 2; ++n) gv[bj][n] = *(const f32x4*)(gp + bj * HALF + 4 * n) * gs;
#pragma unroll
        for (int ai = 0; ai < 2; ++ai) {
            u32x4 xi[4][2];
#pragma unroll
            for (int m = 0; m < 4; ++m)
#pragma unroll
                for (int bj = 0; bj < 2; ++bj) xi[m][bj] = *(const u32x4*)(xin + (size_t)(row0 + ai * HALF + m * 16) * 1024 + col0 + bj * HALF);
            asm volatile("" ::: "memory");
#pragma unroll
            for (int m = 0; m < 4; ++m)
#pragma unroll
                for (int bj = 0; bj < 2; ++bj) { const u32x4 x = xi[m][bj]; const f32x4 a0 = acc[ai][bj][m][0], a1 = acc[ai][bj][m][1], g0 = gv[bj][0], g1 = gv[bj][1];
                    u32x4 w;
                    w.x = cvt_pk_bf16(__builtin_bit_cast(float, x.x << 16) + g0[0] * a0[0], __builtin_bit_cast(float, x.x & 0xffff0000u) + g0[1] * a0[1]);
                    w.y = cvt_pk_bf16(__builtin_bit_cast(float, x.y << 16) + g0[2] * a0[2], __builtin_bit_cast(float, x.y & 0xffff0000u) + g0[3] * a0[3]);
                    w.z = cvt_pk_bf16(__builtin_bit_cast(float, x.z << 16) + g1[0] * a1[0], __builtin_bit_cast(float, x.z & 0xffff0000u) + g1[1] * a1[1]);
                    w.w = cvt_pk_bf16(__builtin_bit_cast(float, x.w << 16) + g1[2] * a1[2], __builtin_bit_cast(float, x.w & 0xffff0000u) + g1[3] * a1[3]);
                    *(u32x4*)(xout + (size_t)(row0 + ai * HALF + m * 16) * 1024 + col0 + bj * HALF) = w; }
            asm volatile("" ::: "memory");
        }
    }
};

template <class Epi, class Sched, bool ALIGN_EPI, int VAR = 0, bool FP8 = false, bool ZC = true>
__device__ __forceinline__ void gemm_phase(PG8_LAS unsigned char* lds, PG8_LAS int* rowtab, const Gemm g, const Sched& S, const Epi& E) {
    int tid_ = threadIdx.x; asm volatile("" : "+v"(tid_));
    const int tid = tid_, wid = __builtin_amdgcn_readfirstlane(tid >> 6), lane = tid & 63, wr = wid >> 2, wc = wid & 3, fr = lane & 15, fq = lane >> 4;
    const int K = g.K, nt = K / BK;
    unsigned voffA[2], voffB[2];
#pragma unroll
    for (int i = 0; i < 2; ++i) { int R, C; stage_rc(tid * 16 + i * 8192, R, C); const int Rb = Epi::PERM ? ((R & ~31) + perm32(R & 31)) : R;
        voffA[i] = (unsigned)(R * K + C) * 2u; voffB[i] = (unsigned)(Rb * K + C) * 2u; }
    const size_t kstep = (size_t)(BK * 2);
    const size_t hstep = (size_t)HALF * K * 2;
    const unsigned ldsw = (unsigned)wid * 1024u;
    const int aoff = lds_byte(wr * 64 + fr, fq * 8), boff = lds_byte(wc * 32 + fr, fq * 8);
#define PG8_SA(b, h) (((b) * 2 + (h)) * HTB)
#define PG8_SB(b, h) ((4 + (b) * 2 + (h)) * HTB)
#define PG8_STAGE(bufoff, gbase, voff) do { if constexpr (VAR != 2) _Pragma("unroll") for (int _i = 0; _i < 2; ++_i) \
        __builtin_amdgcn_global_load_lds((const unsigned*)((const char*)(gbase) + (voff)[_i]), (PG8_LAS unsigned*)(lds + (bufoff) + ldsw + _i * 8192), 16, 0, 0); } while (0)
#define PG8_STA(bufoff, h, ptr, GO) do { if constexpr (Sched::GATHER) { PG8_STAGE(bufoff, ptr, GO[h]); } else { PG8_STAGE(bufoff, (ptr) + (h) * hstep, voffA); } } while (0)
#define PG8_LDA(dst, b, h) do { _Pragma("unroll") for (int m = 0; m < 4; ++m) _Pragma("unroll") for (int k = 0; k < 2; ++k) dst[m][k] = *(const PG8_LAS bf16x8*)(lds + PG8_SA(b, h) + aoff + m * 2048 + k * 1024); } while (0)
#define PG8_LDB(dst, b, h) do { _Pragma("unroll") for (int n = 0; n < 2; ++n) _Pragma("unroll") for (int k = 0; k < 2; ++k) dst[n][k] = *(const PG8_LAS bf16x8*)(lds + PG8_SB(b, h) + boff + n * 2048 + k * 1024); } while (0)
#define PG8_MMA(ai, bj, At, Bt) do { __builtin_amdgcn_s_setprio(1); if constexpr (VAR != 1) { if constexpr (FP8) { _Pragma("unroll") for (int m = 0; m < 4; ++m) _Pragma("unroll") for (int n = 0; n < 2; ++n) \
        asm volatile("v_mfma_f32_16x16x128_f8f6f4 %0, %1, %2, %0" : "+v"(acc[ai][bj][m][n]) : "v"(__builtin_shufflevector(__builtin_bit_cast(i32x4_t, Bt[n][0]), __builtin_bit_cast(i32x4_t, Bt[n][1]), 0, 1, 2, 3, 4, 5, 6, 7)), \
            "v"(__builtin_shufflevector(__builtin_bit_cast(i32x4_t, At[m][0]), __builtin_bit_cast(i32x4_t, At[m][1]), 0, 1, 2, 3, 4, 5, 6, 7))); } \
        else { _Pragma("unroll") for (int m = 0; m < 4; ++m) _Pragma("unroll") for (int n = 0; n < 2; ++n) _Pragma("unroll") for (int k = 0; k < 2; ++k) \
        acc[ai][bj][m][n] = __builtin_amdgcn_mfma_f32_16x16x32_bf16(Bt[n][k], At[m][k], acc[ai][bj][m][n], 0, 0, 0); } } __builtin_amdgcn_s_setprio(0); } while (0)
#define PG8_MMA0(ai, bj, At, Bt) do { if constexpr (VAR != 1 && ZC) { if (t == 0) { __builtin_amdgcn_s_setprio(1); \
        if constexpr (FP8) { _Pragma("unroll") for (int m = 0; m < 4; ++m) _Pragma("unroll") for (int n = 0; n < 2; ++n) \
        asm volatile("v_mfma_f32_16x16x128_f8f6f4 %0, %1, %2, 0" : "+v"(acc[ai][bj][m][n]) : "v"(__builtin_shufflevector(__builtin_bit_cast(i32x4_t, Bt[n][0]), __builtin_bit_cast(i32x4_t, Bt[n][1]), 0, 1, 2, 3, 4, 5, 6, 7)), \
            "v"(__builtin_shufflevector(__builtin_bit_cast(i32x4_t, At[m][0]), __builtin_bit_cast(i32x4_t, At[m][1]), 0, 1, 2, 3, 4, 5, 6, 7))); } \
        else { _Pragma("unroll") for (int m = 0; m < 4; ++m) _Pragma("unroll") for (int n = 0; n < 2; ++n) asm volatile("v_mfma_f32_16x16x32_bf16 %0, %1, %2, 0" : "+v"(acc[ai][bj][m][n]) : "v"(Bt[n][0]), "v"(At[m][0])); \
               _Pragma("unroll") for (int m = 0; m < 4; ++m) _Pragma("unroll") for (int n = 0; n < 2; ++n) asm volatile("v_mfma_f32_16x16x32_bf16 %0, %1, %2, %0" : "+v"(acc[ai][bj][m][n]) : "v"(Bt[n][1]), "v"(At[m][1])); } \
        __builtin_amdgcn_s_setprio(0); } else { PG8_MMA(ai, bj, At, Bt); } } else { PG8_MMA(ai, bj, At, Bt); } } while (0)
#define PG8_WAIT_V(n) asm volatile("s_waitcnt vmcnt(" #n ")" ::: "memory")
#define PG8_WAIT_L(n) asm volatile("s_waitcnt lgkmcnt(" #n ")" ::: "memory")
#define PG8_BAR __builtin_amdgcn_s_barrier()
#define PG8_SCHED __builtin_amdgcn_sched_barrier(0)
    Unit cur, nxt; int ui = 0;
    if (!S.next(0, cur)) return;
    unsigned gc[2][2], gs[2][2];
    if constexpr (Sched::GATHER) {
        Unit tu;
        for (int i = 0; i < 16 && S.next(i, tu); ++i) if (tid < 256) rowtab[i * 256 + tid] = S.row_index(tu, tid);
        asm volatile("s_waitcnt vmcnt(0) lgkmcnt(0)" ::: "memory"); PG8_BAR; asm volatile("" ::: "memory");
#pragma unroll
        for (int h = 0; h < 2; ++h)
#pragma unroll
            for (int i = 0; i < 2; ++i) { int R, C; stage_rc(tid * 16 + i * 8192, R, C); gc[h][i] = (unsigned)rowtab[h * HALF + R] * (unsigned)(K * 2) + (unsigned)C * 2u; gs[h][i] = gc[h][i]; }
    } else {
#pragma unroll
        for (int h = 0; h < 2; ++h)
#pragma unroll
            for (int i = 0; i < 2; ++i) { gc[h][i] = 0u; gs[h][i] = 0u; }
    }
    f32x4 acc[2][2][4][2];
#pragma unroll
    for (int a = 0; a < 2; ++a)
#pragma unroll
        for (int b = 0; b < 2; ++b)
#pragma unroll
            for (int m = 0; m < 4; ++m)
#pragma unroll
                for (int n = 0; n < 2; ++n) acc[a][b][m][n] = (f32x4){0.f, 0.f, 0.f, 0.f};
    bf16x8 At[4][2], B0[2][2], B1[2][2];
    const char* cA = S.a_base(g, cur); const char* cB = S.b_base(g, cur);
    PG8_STAGE(PG8_SB(0, 0), cB, voffB); PG8_STAGE(PG8_SB(0, 1), cB + hstep, voffB); PG8_STA(PG8_SA(0, 0), 0, cA, gc); PG8_STA(PG8_SA(0, 1), 1, cA, gc);
    if (wr == 1) PG8_BAR;
    PG8_WAIT_V(2); PG8_BAR;
    PG8_STAGE(PG8_SB(1, 0), cB + kstep, voffB); PG8_STA(PG8_SA(1, 0), 0, cA + kstep, gc); PG8_STAGE(PG8_SB(1, 1), cB + hstep + kstep, voffB);
    PG8_WAIT_V(6); PG8_BAR;
    for (;;) {
        const bool has_next = S.next(ui + 1, nxt);
        const char* nA = has_next ? S.a_base(g, nxt) : cA; const char* nB = has_next ? S.b_base(g, nxt) : cB;
        for (int t = 0; t < nt; t += 2) {
            const bool last = (t == nt - 2);
            const char* a1 = cA + (size_t)(t + 1) * kstep;
            const char* a2 = last ? nA : cA + (size_t)(t + 2) * kstep; const char* b2 = last ? nB : cB + (size_t)(t + 2) * kstep;
            const char* a3 = a2 + kstep; const char* b3 = b2 + kstep;
            if constexpr (Sched::GATHER) {
                if (last && has_next) {
#pragma unroll
                    for (int h = 0; h < 2; ++h)
#pragma unroll
                        for (int i = 0; i < 2; ++i) { int t2 = tid; asm volatile("" : "+v"(t2)); int R, C; stage_rc(t2 * 16 + i * 8192, R, C); gs[h][i] = (unsigned)rowtab[(ui + 1) * 256 + h * HALF + R] * (unsigned)(K * 2) + (unsigned)C * 2u; }
                }
            }
            PG8_LDB(B0, 0, 0); PG8_LDB(B1, 0, 1); PG8_SCHED; PG8_LDA(At, 0, 0); PG8_STA(PG8_SA(1, 1), 1, a1, gc);
            PG8_WAIT_V(8); PG8_WAIT_L(0); PG8_BAR; PG8_MMA0(0, 0, At, B0); PG8_MMA0(0, 1, At, B1); PG8_BAR; PG8_SCHED;
            PG8_LDA(At, 0, 1); PG8_STAGE(PG8_SB(0, 0), b2, voffB); PG8_STAGE(PG8_SB(0, 1), b2 + hstep, voffB); PG8_STA(PG8_SA(0, 0), 0, a2, gs);
            PG8_WAIT_V(8); PG8_WAIT_L(0); PG8_BAR; PG8_MMA0(1, 0, At, B0); PG8_MMA0(1, 1, At, B1); PG8_BAR; PG8_SCHED;
            PG8_LDB(B0, 1, 0); PG8_LDB(B1, 1, 1); PG8_SCHED; PG8_LDA(At, 1, 0); PG8_STA(PG8_SA(0, 1), 1, a2, gs);
            PG8_WAIT_V(8); PG8_WAIT_L(0); PG8_BAR; PG8_MMA(0, 0, At, B0); PG8_MMA(0, 1, At, B1); PG8_BAR; PG8_SCHED;
            PG8_LDA(At, 1, 1); PG8_STAGE(PG8_SB(1, 0), b3, voffB); PG8_STAGE(PG8_SB(1, 1), b3 + hstep, voffB); PG8_STA(PG8_SA(1, 0), 0, a3, gs);
            PG8_WAIT_V(8); PG8_WAIT_L(0); PG8_BAR; PG8_MMA(1, 0, At, B0); PG8_MMA(1, 1, At, B1); PG8_BAR; PG8_SCHED;
        }
        if constexpr (ALIGN_EPI) { if (wr == 0) PG8_BAR; }
        if constexpr (FP8) asm volatile("s_nop 15\n\ts_nop 15" ::: "memory");
        if constexpr (VAR != 3) E(acc, cur, wr, wc, fr, fq);
        if (!has_next) break;
        if constexpr (VAR == 1 || !ZC) {
#pragma unroll
        for (int a = 0; a < 2; ++a)
#pragma unroll
            for (int b = 0; b < 2; ++b)
#pragma unroll
                for (int m = 0; m < 4; ++m)
#pragma unroll
                    for (int n = 0; n < 2; ++n) acc[a][b][m][n] = (f32x4){0.f, 0.f, 0.f, 0.f};
        }
        cur = nxt; cA = nA; cB = nB; ++ui;
        if constexpr (Sched::GATHER) {
#pragma unroll
            for (int h = 0; h < 2; ++h)
#pragma unroll
                for (int i = 0; i < 2; ++i) gc[h][i] = gs[h][i];
        }
        if constexpr (ALIGN_EPI) { if (wr == 1) PG8_BAR; }
    }
    PG8_WAIT_V(0);
    if constexpr (!ALIGN_EPI) { if (wr == 0) PG8_BAR; }
    PG8_BAR;
#undef PG8_SA
#undef PG8_SB
#undef PG8_STAGE
#undef PG8_STA
#undef PG8_LDA
#undef PG8_LDB
#undef PG8_MMA
#undef PG8_MMA0
#undef PG8_WAIT_V
#undef PG8_WAIT_L
#undef PG8_BAR
#undef PG8_SCHED
}
}

#define GAS __attribute__((address_space(1)))
#define LAS __attribute__((address_space(3)))
typedef unsigned short bf16;
typedef unsigned v4u __attribute__((ext_vector_type(4)));
typedef float f32x4 __attribute__((ext_vector_type(4)));
typedef short bf16x8 __attribute__((ext_vector_type(8)));
typedef GAS unsigned gu32;
typedef GAS unsigned long long gu64;
#define RLX_AGENT __ATOMIC_RELAXED, __HIP_MEMORY_SCOPE_AGENT
#define LDS_WAIT() asm volatile("s_waitcnt lgkmcnt(0)" ::: "memory")
#define VM_WAIT() asm volatile("s_waitcnt vmcnt(0)" ::: "memory")
__device__ __forceinline__ unsigned long long rt() { return __builtin_amdgcn_s_memrealtime(); }
__device__ __forceinline__ unsigned f2bf(float f) { unsigned u = __builtin_bit_cast(unsigned, f); return (u + 0x7fffu + ((u >> 16) & 1u)) >> 16; }
__device__ __forceinline__ unsigned pk2(float lo, float hi) { return f2bf(lo) | (f2bf(hi) << 16); }

#define XB_TMO      128
#define XB_XCNT(j)  (256  + 64 * (j))
#define XB_XSUB(j)  (1280 + 64 * (j))
#define XB_XGEN(j)  (2304 + 64 * (j))
#define XB_TOP      3328
#define XB_TOPGEN   3392
#define XCD_BAR_WORDS 3456
#define XB_SPIN_CAP (1u << 18)

__device__ __forceinline__ unsigned xb_ld(unsigned* p)              { return __hip_atomic_load(p, __ATOMIC_RELAXED, __HIP_MEMORY_SCOPE_AGENT); }
__device__ __forceinline__ unsigned xb_add(unsigned* p, unsigned v) { return __hip_atomic_fetch_add(p, v, __ATOMIC_RELAXED, __HIP_MEMORY_SCOPE_AGENT); }
__device__ __forceinline__ unsigned xb_xcc_id() { return (unsigned)__builtin_amdgcn_s_getreg((3 << 11) | 20) & 0xFu; }
#define XB_SPIN(cond, bar) do { unsigned _sp = 0; while (cond) { __builtin_amdgcn_s_sleep(1); \
    if ((++_sp & 255u) == 0u) { if (xb_ld(&(bar)[XB_TMO])) break; if (_sp > XB_SPIN_CAP) { atomicAdd(&(bar)[XB_TMO], 1u); break; } } } } while (0)

struct XcdBarrier {
    unsigned* bar; unsigned x;
    volatile LAS unsigned* st;
};

__device__ __forceinline__ XcdBarrier xcd_barrier_post(unsigned* bar, volatile LAS unsigned* st) {
    XcdBarrier b; b.bar = bar; b.x = xb_xcc_id(); b.st = st;
    if (threadIdx.x == 0) (void)xb_add(&bar[XB_XCNT(b.x)], 1u);
    return b;
}
__device__ __forceinline__ void xcd_barrier_complete(unsigned* bar, unsigned x, unsigned& nloc, unsigned& nx) {
    const unsigned G = gridDim.x * gridDim.y * gridDim.z;
    unsigned sum, cnt, mine, sp = 0u;
    for (;;) {
        sum = 0u; cnt = 0u; mine = 0u;
#pragma unroll
        for (unsigned j = 0; j < 16; ++j) { const unsigned c = xb_ld(&bar[XB_XCNT(j)]); sum += c; cnt += (c > 0u) ? 1u : 0u; mine = (j == x) ? c : mine; }
        if (sum == G) break;
        __builtin_amdgcn_s_sleep(1);
        if ((++sp & 255u) == 0u) { if (xb_ld(&bar[XB_TMO])) break; if (sp > XB_SPIN_CAP) { atomicAdd(&bar[XB_TMO], 1u); break; } }
    }
    nloc = mine > 0u ? mine : 1u; nx = cnt > 0u ? cnt : 1u;
}

__device__ __forceinline__ void xcd_barrier(const XcdBarrier& b) {
    asm volatile("s_waitcnt vmcnt(0)" ::: "memory");
    __syncthreads();
    if (threadIdx.x == 0) {
        unsigned* bar = b.bar;
        __builtin_amdgcn_s_waitcnt(0);
        unsigned nloc = b.st[0], nx = b.st[1];
        if (nloc == 0u) { xcd_barrier_complete(bar, b.x, nloc, nx); b.st[0] = nloc; b.st[1] = nx; }
        const unsigned old = xb_add(&bar[XB_XSUB(b.x)], 1u);
        const unsigned gen = old / nloc;
        if (old + 1u == (gen + 1u) * nloc) {
            __builtin_amdgcn_fence(__ATOMIC_RELEASE, "agent");
            asm volatile("s_waitcnt vmcnt(0)" ::: "memory");
            const unsigned og = xb_add(&bar[XB_TOP], 1u);
            const unsigned tg = og / nx;
            if (og + 1u == (tg + 1u) * nx) xb_add(&bar[XB_TOPGEN], 1u);
            else XB_SPIN(xb_ld(&bar[XB_TOPGEN]) == tg, bar);
            __builtin_amdgcn_fence(__ATOMIC_ACQUIRE, "agent");
            xb_add(&bar[XB_XGEN(b.x)], 1u);
            asm volatile("s_waitcnt vmcnt(0)" ::: "memory");
        } else {
            XB_SPIN(xb_ld(&bar[XB_XGEN(b.x)]) == gen, bar);
            __builtin_amdgcn_fence(__ATOMIC_ACQUIRE, "agent");
            asm volatile("s_waitcnt vmcnt(0)" ::: "memory");
        }
    }
    __syncthreads();
}


constexpr int NWAVES = 8;
constexpr int NB = 32, SEQ = 2048, T = NB * SEQ, DM = 1024, DEPTH = 4;
constexpr int NPROJ = 3328;
constexpr int NIN = 3088;
constexpr int FF = 2816, FFE = 3584, NE = 8;
constexpr int NMOD = 6 * DM;
constexpr float EPS = 1e-6f;
constexpr bool G1_FP8 = false, G3_FP8 = true, G4_FP8 = true;
constexpr int C_CB = 0, C_CC = 256, C_CX = 512, C_SU = 768, C_SV = 1024;
constexpr int C_GLA = 1280, GLA_W = 224, C_HGR = 2176, HGR_W = 256;
static_assert(C_HGR == C_GLA + 4 * GLA_W && C_HGR + 4 * HGR_W == 3200, "projection column map");
constexpr int MOE_ROWS = 2 * T + NE * 256;
constexpr int CH_PAN = 128, CH0_MAX = 136;
constexpr int N_CHUNK = 4;
constexpr int MOE_HQ = CH_PAN * (2 * FFE / 256) / 256 - 3;
static_assert((N_CHUNK - 1) * CH_PAN + CH0_MAX >= MOE_ROWS / 256, "MoE chunks cover every panel");

constexpr size_t MiB = 1u << 20;
constexpr size_t WS_CTL = 0, CTL_ZERO_BYTES = 64 * 1024;
constexpr size_t WS_MOD = 1 * MiB;
constexpr size_t WS_LB = 4 * MiB;
constexpr size_t WS_RE = 5 * MiB;
constexpr size_t WS_RW = 5 * MiB + 512 * 1024;
constexpr size_t WS_RP = 6 * MiB;
constexpr size_t WS_RM = 7 * MiB;
constexpr size_t WS_WIN = 8 * MiB;
constexpr size_t WS_WOUT = 34 * MiB;
constexpr size_t WS_W13D = 42 * MiB;
constexpr size_t WS_W2D = 64 * MiB;
constexpr size_t WS_W13E = 75 * MiB;
constexpr size_t WS_W2E = 299 * MiB;
constexpr size_t WS_H = 411 * MiB;
constexpr size_t WS_MIX = 539 * MiB;
constexpr size_t WS_PROJ = 667 * MiB;
constexpr size_t WS_HID = WS_PROJ;
constexpr size_t WS_YS = WS_MIX;
constexpr size_t WS_HIDC = 799 * MiB;
constexpr size_t WS_XB2 = 42 * MiB;
constexpr size_t WS_END = 1083 * MiB;
constexpr size_t W13E_LSTRIDE = (size_t)8 * 2 * FFE * DM * 2;
static_assert(WS_WIN + (size_t)4 * NPROJ * DM * 2 <= WS_WOUT && WS_W13D + (size_t)2 * 2 * FF * DM * 2 <= WS_W2D && WS_W2D + (size_t)2 * DM * FF * 2 <= WS_W13E, "ws map 1");
static_assert(WS_W13E + (size_t)16 * 2 * FFE * DM * 2 <= WS_W2E && WS_W2E + (size_t)16 * DM * FFE * 2 <= WS_H && WS_H + (size_t)T * DM * 2 <= WS_MIX && WS_MIX + (size_t)T * DM * 2 <= WS_PROJ, "ws map 2");
static_assert(WS_PROJ + (size_t)T * NPROJ * 2 <= WS_END && WS_HID + (size_t)T * FF * 2 <= WS_END && WS_YS + (size_t)MOE_ROWS * DM * 2 <= WS_HIDC && WS_HIDC + (size_t)2 * CH0_MAX * 256 * FFE <= WS_END, "ws map 3");
static_assert(WS_RM + (size_t)MOE_ROWS * 4 <= WS_WIN, "ws map 4");
static_assert(WS_XB2 >= WS_W13D && WS_XB2 + (size_t)T * DM * 2 <= WS_W13E + (size_t)8 * 2 * FFE * DM * 2, "the late residual copy only covers weights of finished layers");
constexpr int CW_TMO = 0, CW_CODE = 1;
constexpr int CW_BAR = 4096;
constexpr int CW_MOE = 8192;

constexpr int RING_OFF = 0, RING_BYTES = 131072;
constexpr int LDSCTL_OFF = RING_BYTES;
constexpr int ROWTAB_OFF = RING_BYTES + 1024;
constexpr int ROWTAB_UNITS = 16;
constexpr int LDS_BYTES = 151552;
static_assert(ROWTAB_OFF + ROWTAB_UNITS * 1024 <= LDS_BYTES, "LDS map");


typedef float f32x2 __attribute__((ext_vector_type(2)));
typedef unsigned u32x2 __attribute__((ext_vector_type(2)));
typedef int i32x2 __attribute__((ext_vector_type(2)));
#define KARG(i) (*(const float* const volatile __attribute__((address_space(4)))*)((const __attribute__((address_space(4))) char*)__builtin_amdgcn_kernarg_segment_ptr() + 8 * (i)))
struct Frame {
    LAS unsigned char* lds;
    volatile LAS unsigned* MISC;
    gu32* ctl;
    unsigned char* ws;
    float* out;
    int tid, lane, wave, vcu, G;
};
#define LDS_BARRIER() do { asm volatile("s_waitcnt lgkmcnt(0)" ::: "memory"); __builtin_amdgcn_s_barrier(); asm volatile("" ::: "memory"); } while (0)
__device__ __forceinline__ float wave_sum(float v) {
#pragma unroll
    for (int o = 1; o < 64; o <<= 1) v += __shfl_xor(v, o);
    return v;
}
__device__ __forceinline__ float bflo(unsigned u) { return __builtin_bit_cast(float, u << 16); }
__device__ __forceinline__ float bfhi(unsigned u) { return __builtin_bit_cast(float, u & 0xffff0000u); }
__device__ __forceinline__ f32x4 ld_bf4(const bf16* p) { const u32x2 u = *(const u32x2*)p; return (f32x4){bflo(u.x), bfhi(u.x), bflo(u.y), bfhi(u.y)}; }
__device__ __forceinline__ void st_bf4(bf16* p, f32x4 v) { u32x2 u; u.x = pg8::cvt_pk_bf16(v[0], v[1]); u.y = pg8::cvt_pk_bf16(v[2], v[3]); *(u32x2*)p = u; }
__device__ __forceinline__ f32x4 ld_bf4_reg(f32x4 v) { const unsigned a = pg8::cvt_pk_bf16(v[0], v[1]), c = pg8::cvt_pk_bf16(v[2], v[3]); return (f32x4){bflo(a), bfhi(a), bflo(c), bfhi(c)}; }
__device__ __forceinline__ float sigmoid_f(float x) { return __builtin_amdgcn_rcpf(1.0f + __expf(-x)); }
__device__ __forceinline__ float silu_f(float x) { return x * sigmoid_f(x); }
__device__ __forceinline__ float logsigmoid_f(float z) { return fminf(z, 0.f) - __logf(1.0f + __expf(-fabsf(z))); }

__device__ __forceinline__ void p0_item(const float* W, int ldw, int k0, int ns0, bf16* WT, int ldt, int drow0, int nvalid, LAS float* scr, int lane, float scale = 1.0f) {
    {   const int seg = lane & 7, r8 = lane >> 3;
        f32x4 v[8];
#pragma unroll
        for (int i = 0; i < 8; ++i) v[i] = *(const f32x4*)(W + (size_t)(k0 + 8 * i + r8) * ldw + ns0 + 4 * seg);
        asm volatile("" ::: "memory");
#pragma unroll
        for (int i = 0; i < 8; ++i) { LAS float* sp = scr + (8 * i + r8) * 33 + 4 * seg; sp[0] = v[i][0] * scale; sp[1] = v[i][1] * scale; sp[2] = v[i][2] * scale; sp[3] = v[i][3] * scale; }
    }
    LDS_WAIT(); asm volatile("" ::: "memory");
    const int c = lane & 7;
#pragma unroll
    for (int j = 0; j < 4; ++j) { const int n = (lane >> 3) + 8 * j; const LAS float* s = scr + (8 * c) * 33 + n;
        v4u o; o.x = pk2(s[0 * 33], s[1 * 33]); o.y = pk2(s[2 * 33], s[3 * 33]); o.z = pk2(s[4 * 33], s[5 * 33]); o.w = pk2(s[6 * 33], s[7 * 33]);
        if (n >= nvalid) o = (v4u){0u, 0u, 0u, 0u};
        *(GAS v4u*)(WT + (size_t)(drow0 + n) * ldt + k0 + 8 * c) = o; }
    LDS_WAIT(); asm volatile("" ::: "memory");
}
__device__ __forceinline__ void p0_item8(const float* W, int ldw, int k0, int ns0, unsigned char* WT8, int ldt, int drow0, LAS float* scr, int lane, float scale) {
    {   const int seg = lane & 7, r8 = lane >> 3;
        f32x4 v[8];
#pragma unroll
        for (int i = 0; i < 8; ++i) v[i] = *(const f32x4*)(W + (size_t)(k0 + 8 * i + r8) * ldw + ns0 + 4 * seg);
        asm volatile("" ::: "memory");
#pragma unroll
        for (int i = 0; i < 8; ++i) { LAS float* sp = scr + (8 * i + r8) * 33 + 4 * seg; sp[0] = v[i][0] * scale; sp[1] = v[i][1] * scale; sp[2] = v[i][2] * scale; sp[3] = v[i][3] * scale; }
    }
    LDS_WAIT(); asm volatile("" ::: "memory");
    const int c = lane & 7;
#pragma unroll
    for (int j = 0; j < 4; ++j) { const int n = (lane >> 3) + 8 * j; const LAS float* s = scr + (8 * c) * 33 + n;
        pg8::u32x2_t o; o.x = pg8::cvt_pk4_fp8(s[0 * 33], s[1 * 33], s[2 * 33], s[3 * 33]); o.y = pg8::cvt_pk4_fp8(s[4 * 33], s[5 * 33], s[6 * 33], s[7 * 33]);
        *(GAS pg8::u32x2_t*)(WT8 + (size_t)(drow0 + n) * ldt + k0 + 8 * c) = o; }
    LDS_WAIT(); asm volatile("" ::: "memory");
}
__device__ __forceinline__ int swi_row(int ns0) { return 256 * (ns0 >> 7) + (ns0 & 127); }

__device__ __forceinline__ void p0_prologue(Frame& F) {
    unsigned char* ws = F.ws;
    __syncthreads();
    for (int u = F.vcu; u < 48; u += F.G) {
        LAS float* condT = (LAS float*)(F.lds + RING_OFF);
        const float* cin = KARG(1);
        for (int idx = F.tid; idx < 32768; idx += NWAVES * 64) { const int k = idx >> 5, b = idx & 31; const float cv = cin[b * 1024 + k]; condT[idx] = cv * sigmoid_f(cv); }
        __syncthreads();
        const int l = u / 12, n = (u % 12) * 512 + F.tid;
        pg8::f32x2_t acc2[16];
#pragma unroll
        for (int b = 0; b < 16; ++b) acc2[b] = (pg8::f32x2_t){0.f, 0.f};
        const float* wp = KARG(5) + (size_t)l * 1024 * NMOD + n;
#pragma unroll 4
        for (int k = 0; k < 1024; ++k) { const float w = wp[(size_t)k * NMOD]; const pg8::f32x2_t w2 = {w, w};
#pragma unroll
            for (int b4 = 0; b4 < 8; ++b4) { const f32x4 cv = *(const LAS f32x4*)(condT + k * 32 + 4 * b4);
                acc2[2 * b4] = __builtin_elementwise_fma((pg8::f32x2_t){cv[0], cv[1]}, w2, acc2[2 * b4]); acc2[2 * b4 + 1] = __builtin_elementwise_fma((pg8::f32x2_t){cv[2], cv[3]}, w2, acc2[2 * b4 + 1]); } }
        float* mod = (float*)(ws + WS_MOD); const float bb = KARG(6)[l * NMOD + n];
#pragma unroll
        for (int b = 0; b < 16; ++b) { mod[(size_t)(l * 32 + 2 * b) * NMOD + n] = acc2[b].x + bb; mod[(size_t)(l * 32 + 2 * b + 1) * NMOD + n] = acc2[b].y + bb; }
        __syncthreads();
    }
    if (F.vcu == F.G - 1 && F.tid < 256) {
        const int c = F.tid; const float* h = KARG(16); float* lb = (float*)(ws + WS_LB);
        const float h0 = h[c], h1 = h[256 + c], h2 = h[512 + c], h3 = h[768 + c], mx = fmaxf(fmaxf(h0, h1), fmaxf(h2, h3));
        const float e0 = __expf(h0 - mx), e1 = __expf(h1 - mx), e2 = __expf(h2 - mx), e3 = __expf(h3 - mx), inv = 1.0f / (e0 + e1 + e2 + e3);
        lb[c] = 0.f; lb[256 + c] = e1 * inv; lb[512 + c] = (e1 + e2) * inv; lb[768 + c] = (e1 + e2 + e3) * inv;
    }
    {   bf16* WIN = (bf16*)(ws + WS_WIN); unsigned char* WIN8 = ws + WS_WIN; const int per = 128 * 1024 / (G1_FP8 ? 16 : 8);
        for (int idx = F.vcu * NWAVES * 64 + F.tid; idx < 4 * per; idx += F.G * NWAVES * 64) { const int l = idx / per, r = idx % per;
            if constexpr (G1_FP8) *(GAS v4u*)(WIN8 + (size_t)l * NPROJ * 1024 + (size_t)3200 * 1024 + (size_t)r * 16) = (v4u){0u, 0u, 0u, 0u};
            else *(GAS v4u*)(WIN + (size_t)l * NPROJ * 1024 + (size_t)3200 * 1024 + (size_t)r * 8) = (v4u){0u, 0u, 0u, 0u}; }
        const float* win = KARG(7); const float* wgt = KARG(13);
        for (int idx = F.vcu * NWAVES * 64 + F.tid; idx < 4 * 128 * 1024; idx += F.G * NWAVES * 64) { const int dd = idx & 1023, cc = (idx >> 10) & 127, l = idx >> 17;
            const float* wi = win + ((size_t)l * 1024 + dd) * NIN + 1792; const float* wg = wgt + (size_t)l * 2048 + cc;
            const f32x4 a0 = *(const f32x4*)wi, a1 = *(const f32x4*)(wi + 4), a2 = *(const f32x4*)(wi + 8), a3 = *(const f32x4*)(wi + 12);
            float s = 0.f;
#pragma unroll
            for (int r = 0; r < 4; ++r) { s += a0[r] * wg[r * 128]; s += a1[r] * wg[(4 + r) * 128]; s += a2[r] * wg[(8 + r) * 128]; s += a3[r] * wg[(12 + r) * 128]; }
            if constexpr (G1_FP8) WIN8[(size_t)l * NPROJ * 1024 + (size_t)(C_GLA + GLA_W * (cc >> 5) + 192 + (cc & 31)) * 1024 + dd] = (unsigned char)(pg8::cvt_pk4_fp8(s * pg8::W13_8_SCALE, 0.f, 0.f, 0.f) & 0xffu);
            else WIN[(size_t)l * NPROJ * 1024 + (size_t)(C_GLA + GLA_W * (cc >> 5) + 192 + (cc & 31)) * 1024 + dd] = (bf16)f2bf(s); } }
    LAS float* scr = (LAS float*)(F.lds + RING_OFF + F.wave * 16384);
    const int nmod = F.G < 48 ? F.G : 48, mslot = F.G >= 128 ? 0 : 1, nslot = (F.vcu < nmod) ? mslot : 5, slot0 = (F.vcu < nmod) ? 5 * (F.G - nmod) + F.vcu : 5 * (F.vcu - nmod), NGW = (5 * (F.G - nmod) + mslot * nmod) * NWAVES;
    constexpr int I_IN = 16 * 100, I_OUT = 16 * 32, I_F13 = 16 * 88, I_F2 = 44 * 32, I_E13 = 16 * 112, I_E2 = 56 * 32;
    constexpr int NITEMS = 4 * I_IN + 4 * I_OUT + 4 * I_F13 + 2 * I_F2 + 32 * I_E13 + 16 * I_E2;
    bf16* WIN = (bf16*)(ws + WS_WIN); bf16* WOUT = (bf16*)(ws + WS_WOUT);
    for (int sl = 0; sl < nslot; ++sl)
    for (int it = (slot0 + sl) * NWAVES + F.wave; it < NITEMS; it += NGW) {
        int r = it;
        if (r < 4 * I_IN) { const int l = r / I_IN, q = r % I_IN, kb = q / 100, nb = q % 100; const float* W = KARG(7) + (size_t)l * 1024 * NIN; bf16* D = WIN + (size_t)l * NPROJ * 1024;
            int src = 32 * nb;
            if (nb >= 68) { const int hb = (nb - 68) >> 3, i = (nb - 68) & 7; src = 2064 + 256 * (i >> 1) + 64 * hb + 32 * (i & 1); }
            else if (nb >= 40) { const int hb = (nb - 40) / 7, i = (nb - 40) % 7; src = i == 0 ? 1280 + 32 * hb : i == 1 ? 1408 + 32 * hb : i < 4 ? 1536 + 64 * hb + 32 * (i - 2) : i < 6 ? 1808 + 64 * hb + 32 * (i - 4) : -1; }
            if (src >= 0) { if constexpr (G1_FP8) p0_item8(W, NIN, 64 * kb, src, ws + WS_WIN + (size_t)l * NPROJ * 1024, 1024, 32 * nb, scr, F.lane, pg8::W13_8_SCALE); else p0_item(W, NIN, 64 * kb, src, D, 1024, 32 * nb, 32, scr, F.lane); }
            continue; }
        r -= 4 * I_IN;
        if (r < 4 * I_OUT) { const int l = r / I_OUT, q = r % I_OUT, kb = q / 32, nb = q % 32; p0_item(KARG(8) + (size_t)l * 1024 * 1024, 1024, 64 * kb, 32 * nb, WOUT + (size_t)l * 1024 * 1024, 1024, 32 * nb, 32, scr, F.lane); continue; }
        r -= 4 * I_OUT;
        if (r < 4 * I_F13) { const int m = r / I_F13, q = r % I_F13, kb = q / 88, nb = q % 88, i = m & 1, up = m >> 1;
            if constexpr (G3_FP8) p0_item8((up ? KARG(19) : KARG(18)) + (size_t)i * 1024 * FF, FF, 64 * kb, 32 * nb, ws + WS_W13D + (size_t)i * 2 * FF * 1024, 1024, swi_row(32 * nb) + (up ? 128 : 0), scr, F.lane, (up ? 0.6931471805599453f : 1.4426950408889634f) * pg8::W13_8_SCALE);
            else p0_item((up ? KARG(19) : KARG(18)) + (size_t)i * 1024 * FF, FF, 64 * kb, 32 * nb, (bf16*)(ws + WS_W13D) + (size_t)i * 2 * FF * 1024, 1024, swi_row(32 * nb) + (up ? 128 : 0), 32, scr, F.lane, up ? 0.6931471805599453f : 1.4426950408889634f);
            continue; }
        r -= 4 * I_F13;
        if (r < 2 * I_F2) { const int i = r / I_F2, q = r % I_F2, kb = q / 32, nb = q % 32; if constexpr (G4_FP8) p0_item8(KARG(20) + (size_t)i * FF * 1024, 1024, 64 * kb, 32 * nb, ws + WS_W2D + (size_t)i * 1024 * FF, FF, 32 * nb, scr, F.lane, pg8::W2_8_SCALE);
            else p0_item(KARG(20) + (size_t)i * FF * 1024, 1024, 64 * kb, 32 * nb, (bf16*)(ws + WS_W2D) + (size_t)i * 1024 * FF, FF, 32 * nb, 32, scr, F.lane);
            continue; }
        r -= 2 * I_F2;
        if (r < 32 * I_E13) { const int m = r / I_E13, q = r % I_E13, kb = q / 112, nb = q % 112, le = m & 15, up = m >> 4;
            p0_item8((up ? KARG(23) : KARG(22)) + (size_t)le * 1024 * FFE, FFE, 64 * kb, 32 * nb, ws + WS_W13E + (size_t)(le >> 3) * W13E_LSTRIDE + (size_t)(le & 7) * 2 * FFE * 1024, 1024, swi_row(32 * nb) + (up ? 128 : 0), scr, F.lane, (up ? 0.6931471805599453f : 1.4426950408889634f) * pg8::W13_8_SCALE); continue; }
        r -= 32 * I_E13;
        { const int le = r / I_E2, q = r % I_E2, kb = q / 32, nb = q % 32; p0_item8(KARG(24) + (size_t)le * FFE * 1024, 1024, 64 * kb, 32 * nb, ws + WS_W2E + (size_t)le * 1024 * FFE, FFE, 32 * nb, scr, F.lane, pg8::W2_8_SCALE); }
    }
}

template <bool COMBINE, bool ROUTER, bool XF32, bool H8 = false>
__device__ __forceinline__ void norm_phase(Frame& F, const void* xin_, bf16* xout, const float* gain, const float* modl, int sh_off, int sc_off, const float* modprev, const float* router, int moe_idx) {
    unsigned char* ws = F.ws; bf16* H = (bf16*)(ws + WS_H); const bf16* YS = (const bf16*)(ws + WS_YS);
    int* RE = (int*)(ws + WS_RE); f32x2* RW = (f32x2*)(ws + WS_RW); const i32x2* RP = (const i32x2*)(ws + WS_RP);
    LAS float* wr = (LAS float*)(F.lds + RING_OFF);
    LAS unsigned* lcnt = (LAS unsigned*)(F.MISC + 16);
    if (ROUTER) {
        for (int idx = F.tid; idx < 8192; idx += NWAVES * 64) { const int d = idx >> 3, e = idx & 7, j = d >> 8, rem = d & 255, ln = rem >> 2, i = rem & 3; wr[((j * 4 + i) * 64 + ln) * 8 + e] = router[idx]; }
        if (F.tid < 8) lcnt[F.tid] = 0u;
        __syncthreads();
    }
    const int lane = F.lane;
    constexpr int UR = 2;
    for (int blk = F.vcu; blk < T / 256; blk += F.G) {
    const int b = blk >> 3;
    f32x4 ca[4], cb[4], gfr[4];
    {   const f32x4* g4 = (const f32x4*)gain; const f32x4* sc4 = (const f32x4*)(modl + (size_t)b * NMOD + sc_off); const f32x4* sh4 = (const f32x4*)(modl + (size_t)b * NMOD + sh_off);
#pragma unroll
        for (int j = 0; j < 4; ++j) { ca[j] = g4[64 * j + lane] * (sc4[64 * j + lane] + 1.0f); cb[j] = sh4[64 * j + lane]; gfr[j] = (f32x4){0.f, 0.f, 0.f, 0.f}; }
        if (COMBINE) { const f32x4* gf = (const f32x4*)(modprev + (size_t)b * NMOD + 5 * DM);
#pragma unroll
            for (int j = 0; j < 4; ++j) gfr[j] = gf[64 * j + lane]; }
    }
    const int mbase = blk * 256 + F.wave * 32;
    for (int i0 = 0; i0 < 32; i0 += UR) {
        f32x4 v[UR][4]; f32x4 ya[UR][4], yc[UR][4]; f32x2 ww[UR];
#pragma unroll
        for (int u = 0; u < UR; ++u) { const int m = mbase + i0 + u;
            if (XF32) { const f32x4* xr = (const f32x4*)((const float*)xin_ + (size_t)m * DM);
#pragma unroll
                for (int j = 0; j < 4; ++j) v[u][j] = xr[64 * j + lane]; }
            else { const bf16* xr = (const bf16*)xin_ + (size_t)m * DM;
#pragma unroll
                for (int j = 0; j < 4; ++j) v[u][j] = ld_bf4(xr + 4 * (64 * j + lane)); }
            if (COMBINE) { const i32x2 pp = RP[m]; ww[u] = RW[m];
                const bf16* y0 = YS + (size_t)pp.x * DM; const bf16* y1 = YS + (size_t)pp.y * DM;
#pragma unroll
                for (int j = 0; j < 4; ++j) { ya[u][j] = ld_bf4(y0 + 4 * (64 * j + lane)); yc[u][j] = ld_bf4(y1 + 4 * (64 * j + lane)); } }
        }
        asm volatile("" ::: "memory");
#pragma unroll
        for (int u = 0; u < UR; ++u) { const int m = mbase + i0 + u;
            if (COMBINE) { bf16* xo = xout + (size_t)m * DM;
#pragma unroll
                for (int j = 0; j < 4; ++j) { v[u][j] = v[u][j] + gfr[j] * (ya[u][j] * ww[u].x + yc[u][j] * ww[u].y); st_bf4(xo + 4 * (64 * j + lane), v[u][j]); v[u][j] = ld_bf4_reg(v[u][j]); } }
            if (XF32) { bf16* xo = xout + (size_t)m * DM;
#pragma unroll
                for (int j = 0; j < 4; ++j) { st_bf4(xo + 4 * (64 * j + lane), v[u][j]); v[u][j] = ld_bf4_reg(v[u][j]); } }
            float ss = 0.f;
#pragma unroll
            for (int j = 0; j < 4; ++j) ss += (v[u][j][0] * v[u][j][0] + v[u][j][1] * v[u][j][1]) + (v[u][j][2] * v[u][j][2] + v[u][j][3] * v[u][j][3]);
            const float rstd = rsqrtf(wave_sum(ss) * (1.0f / DM) + EPS);
            bf16* ho = H + (size_t)m * DM;
#pragma unroll
            for (int j = 0; j < 4; ++j) { v[u][j] = v[u][j] * rstd * ca[j] + cb[j];
                if (H8) { const f32x4 q = v[u][j] * (1.0f / pg8::W13_8_SCALE); *(unsigned*)((unsigned char*)H + (size_t)m * DM + 4 * (64 * j + lane)) = pg8::cvt_pk4_fp8(q[0], q[1], q[2], q[3]); }
                else st_bf4(ho + 4 * (64 * j + lane), v[u][j]); }
            if (ROUTER) {
                float lg[8];
#pragma unroll
                for (int e = 0; e < 8; ++e) lg[e] = 0.f;
#pragma unroll
                for (int j = 0; j < 4; ++j)
#pragma unroll
                    for (int i = 0; i < 4; ++i) { const LAS float* wp = wr + ((j * 4 + i) * 64 + lane) * 8; const f32x4 w0 = *(const LAS f32x4*)wp, w1 = *(const LAS f32x4*)(wp + 4); const float y = v[u][j][i];
                        lg[0] += y * w0[0]; lg[1] += y * w0[1]; lg[2] += y * w0[2]; lg[3] += y * w0[3]; lg[4] += y * w1[0]; lg[5] += y * w1[1]; lg[6] += y * w1[2]; lg[7] += y * w1[3]; }
#pragma unroll
                for (int e = 0; e < 8; ++e) lg[e] = wave_sum(lg[e]);
                if (lane == 0) {
                    int e0 = 0; float v0 = lg[0];
#pragma unroll
                    for (int e = 1; e < 8; ++e) if (lg[e] > v0) { v0 = lg[e]; e0 = e; }
                    int e1 = -1; float v1 = -3.0e38f;
#pragma unroll
                    for (int e = 0; e < 8; ++e) if (e != e0 && lg[e] > v1) { v1 = lg[e]; e1 = e; }
                    const float w0 = 1.0f / (1.0f + __expf(v1 - v0));
                    RE[m] = e0 | (e1 << 8); RW[m] = (f32x2){w0 * (1.0f / pg8::W2_8_SCALE), (1.0f - w0) * (1.0f / pg8::W2_8_SCALE)};
                    __hip_atomic_fetch_add(lcnt + e0, 1u, __ATOMIC_RELAXED, __HIP_MEMORY_SCOPE_WORKGROUP); __hip_atomic_fetch_add(lcnt + e1, 1u, __ATOMIC_RELAXED, __HIP_MEMORY_SCOPE_WORKGROUP);
                }
            }
        }
    }
    }
    if (ROUTER) {
        __syncthreads();
        if (F.tid < 8) __hip_atomic_fetch_add(F.ctl + CW_MOE + moe_idx * 64 + F.tid, lcnt[F.tid], RLX_AGENT);
    }
}
__device__ __forceinline__ void final_phase(Frame& F, const float* modprev, const bf16* xb) {
    unsigned char* ws = F.ws; const bf16* YS = (const bf16*)(ws + WS_YS); const f32x2* RW = (const f32x2*)(ws + WS_RW); const i32x2* RP = (const i32x2*)(ws + WS_RP);
    const int lane = F.lane;
    const f32x4* g4 = (const f32x4*)KARG(4);
    f32x4 gn[4];
#pragma unroll
    for (int j = 0; j < 4; ++j) gn[j] = g4[64 * j + lane];
    for (int blk = F.vcu; blk < T / 256; blk += F.G) {
        const int b = blk >> 3; const f32x4* gf = (const f32x4*)(modprev + (size_t)b * NMOD + 5 * DM);
        f32x4 gfr[4];
#pragma unroll
        for (int j = 0; j < 4; ++j) gfr[j] = gf[64 * j + lane];
        const int mbase = blk * 256 + F.wave * 32;
        for (int i0 = 0; i0 < 32; i0 += 2) {
            f32x4 v[2][4], ya[2][4], yc[2][4]; f32x2 ww[2];
#pragma unroll
            for (int u = 0; u < 2; ++u) { const int m = mbase + i0 + u; const bf16* xr = xb + (size_t)m * DM;
                const i32x2 pp = RP[m]; ww[u] = RW[m]; const bf16* y0 = YS + (size_t)pp.x * DM; const bf16* y1 = YS + (size_t)pp.y * DM;
#pragma unroll
                for (int j = 0; j < 4; ++j) { v[u][j] = ld_bf4(xr + 4 * (64 * j + lane)); ya[u][j] = ld_bf4(y0 + 4 * (64 * j + lane)); yc[u][j] = ld_bf4(y1 + 4 * (64 * j + lane)); } }
            asm volatile("" ::: "memory");
#pragma unroll
            for (int u = 0; u < 2; ++u) { const int m = mbase + i0 + u; f32x4* xr = (f32x4*)(F.out + (size_t)m * DM);
                float ss = 0.f;
#pragma unroll
                for (int j = 0; j < 4; ++j) { v[u][j] = v[u][j] + gfr[j] * (ya[u][j] * ww[u].x + yc[u][j] * ww[u].y);
                    ss += (v[u][j][0] * v[u][j][0] + v[u][j][1] * v[u][j][1]) + (v[u][j][2] * v[u][j][2] + v[u][j][3] * v[u][j][3]); }
                const float rstd = rsqrtf(wave_sum(ss) * (1.0f / DM) + EPS);
#pragma unroll
                for (int j = 0; j < 4; ++j) xr[64 * j + lane] = v[u][j] * rstd * gn[j];
            }
        }
    }
}

__device__ __forceinline__ unsigned r256(unsigned x) { return (x + 255u) & ~255u; }
__device__ __forceinline__ void route_phase(Frame& F, int moe_idx) {
    unsigned char* ws = F.ws; const int* RE = (const int*)(ws + WS_RE); i32x2* RP = (i32x2*)(ws + WS_RP); int* RM = (int*)(ws + WS_RM);
    LAS unsigned* lcnt = (LAS unsigned*)(F.MISC + 16); LAS unsigned* lbase = (LAS unsigned*)(F.MISC + 24);
    gu32* gcnt = F.ctl + CW_MOE + moe_idx * 64; gu32* gcur = gcnt + 16;
    unsigned cn[8];
#pragma unroll
    for (int e = 0; e < 8; ++e) cn[e] = __hip_atomic_load(gcnt + e, RLX_AGENT);
    for (int blk = F.vcu; blk < T / 256; blk += F.G) {
        if (F.tid < 8) lcnt[F.tid] = 0u;
        __syncthreads();
        int e0 = 0, e1 = 0; unsigned l0 = 0, l1 = 0; const int tok = blk * 256 + F.tid;
        if (F.tid < 256) { const int ee = RE[tok]; e0 = ee & 255; e1 = ee >> 8;
            l0 = __hip_atomic_fetch_add(lcnt + e0, 1u, __ATOMIC_RELAXED, __HIP_MEMORY_SCOPE_WORKGROUP); l1 = __hip_atomic_fetch_add(lcnt + e1, 1u, __ATOMIC_RELAXED, __HIP_MEMORY_SCOPE_WORKGROUP); }
        __syncthreads();
        if (F.tid < 8) lbase[F.tid] = __hip_atomic_fetch_add(gcur + F.tid, lcnt[F.tid], RLX_AGENT);
        __syncthreads();
        if (F.tid < 256) {
            unsigned o0 = 0, o1 = 0;
#pragma unroll
            for (int j = 0; j < 7; ++j) { o0 += (j < e0) ? r256(cn[j]) : 0u; o1 += (j < e1) ? r256(cn[j]) : 0u; }
            const int p0 = (int)(o0 + lbase[e0] + l0), p1 = (int)(o1 + lbase[e1] + l1);
            RM[p0] = tok; RM[p1] = tok; RP[tok] = (i32x2){p0, p1};
        }
        __syncthreads();
    }
    if (F.vcu < 8) {
        unsigned o = 0;
#pragma unroll
        for (int j = 0; j < 7; ++j) o += (j < F.vcu) ? r256(cn[j]) : 0u;
        unsigned mine = 0;
#pragma unroll
        for (int j = 0; j < 8; ++j) mine = (j == F.vcu) ? cn[j] : mine;
        for (unsigned p = mine + F.tid; p < r256(mine); p += NWAVES * 64) RM[o + p] = 0;
    }
}

__device__ __forceinline__ void conv_item(const bf16* PROJ, bf16* MIX, const float* cw, int idx) {
    const int t = idx >> 5, c8 = (idx & 31) * 8, tin = t & (SEQ - 1);
    const bf16* pr = PROJ + (size_t)t * NPROJ;
    float z[3][8];
#pragma unroll
    for (int d = 0; d < 3; ++d) {
        if (tin >= d) { const bf16* q = pr - (size_t)d * NPROJ; const f32x4 a0 = ld_bf4(q + C_CC + c8), a1 = ld_bf4(q + C_CC + c8 + 4), x0 = ld_bf4(q + C_CX + c8), x1 = ld_bf4(q + C_CX + c8 + 4);
#pragma unroll
            for (int i = 0; i < 4; ++i) { z[d][i] = a0[i] * x0[i]; z[d][4 + i] = a1[i] * x1[i]; } }
        else {
#pragma unroll
            for (int i = 0; i < 8; ++i) z[d][i] = 0.f; }
    }
    const f32x4 b0 = ld_bf4(pr + C_CB + c8), b1 = ld_bf4(pr + C_CB + c8 + 4);
    float y[8];
#pragma unroll
    for (int i = 0; i < 8; ++i) { const float bb = i < 4 ? b0[i & 3] : b1[i & 3]; y[i] = bb * (cw[c8 + i] * z[2][i] + cw[256 + c8 + i] * z[1][i] + cw[512 + c8 + i] * z[0][i]); }
    v4u o; o.x = pg8::cvt_pk_bf16(y[0], y[1]); o.y = pg8::cvt_pk_bf16(y[2], y[3]); o.z = pg8::cvt_pk_bf16(y[4], y[5]); o.w = pg8::cvt_pk_bf16(y[6], y[7]);
    *(v4u*)(MIX + (size_t)t * DM + c8) = o;
}
__device__ __forceinline__ void conv_phase(Frame& F, int layer) {
    const bf16* PROJ = (const bf16*)(F.ws + WS_PROJ); bf16* MIX = (bf16*)(F.ws + WS_MIX); const float* cw = KARG(9) + layer * 768;
    for (int idx = F.vcu * NWAVES * 64 + F.tid; idx < T * 32; idx += F.G * NWAVES * 64) conv_item(PROJ, MIX, cw, idx);
}

__device__ __forceinline__ void sgu_unit(Frame& F, int layer, int b, int ch) {
    constexpr int LP = 136, OP = 72;
    LAS bf16* vnT = (LAS bf16*)(F.lds + RING_OFF); LAS bf16* Wb = (LAS bf16*)(F.lds + RING_OFF + 256 * LP * 2); LAS bf16* OT = (LAS bf16*)(F.lds + RING_OFF + 256 * LP * 2 + 128 * LP * 2);
    static_assert(256 * LP * 2 + 128 * LP * 2 + 128 * OP * 2 <= RING_BYTES, "SGU LDS map");
    const bf16* PROJ = (const bf16*)(F.ws + WS_PROJ); bf16* MIX = (bf16*)(F.ws + WS_MIX);
    const size_t row0 = (size_t)b * SEQ + (size_t)ch * 128; const int lane = F.lane, w = F.wave, tid = F.tid;
    __syncthreads();
    const int wt = tid >> 2, wsq = (tid & 3) * 32;
    f32x4 wa[4], wc[4];
    { const float* wsrc = KARG(11) + ((size_t)(layer * 4) * 128 + wt) * 128 + wsq;
#pragma unroll
      for (int c8 = 0; c8 < 4; ++c8) { wa[c8] = *(const f32x4*)(wsrc + 8 * c8); wc[c8] = *(const f32x4*)(wsrc + 8 * c8 + 4); } }
    {
        const int s = 16 * w + (lane >> 2), q = lane & 3; const bf16* src = PROJ + (row0 + s) * NPROJ + C_SV + 64 * q;
        v4u raw[8];
#pragma unroll
        for (int i = 0; i < 8; ++i) raw[i] = *(const v4u*)(src + 8 * i);
        float x[64]; float sm = 0.f, sq = 0.f;
#pragma unroll
        for (int i = 0; i < 8; ++i) { x[8 * i] = bflo(raw[i].x); x[8 * i + 1] = bfhi(raw[i].x); x[8 * i + 2] = bflo(raw[i].y); x[8 * i + 3] = bfhi(raw[i].y); x[8 * i + 4] = bflo(raw[i].z); x[8 * i + 5] = bfhi(raw[i].z); x[8 * i + 6] = bflo(raw[i].w); x[8 * i + 7] = bfhi(raw[i].w); }
#pragma unroll
        for (int i = 0; i < 64; ++i) { sm += x[i]; sq += x[i] * x[i]; }
        sm += __shfl_xor(sm, 1); sq += __shfl_xor(sq, 1); sm += __shfl_xor(sm, 2); sq += __shfl_xor(sq, 2);
        const float mu = sm * (1.0f / 256.0f), var = fmaxf(sq * (1.0f / 256.0f) - mu * mu, 0.f), rstd = rsqrtf(var + EPS);
        const float* gp = KARG(10) + layer * 256 + 64 * q;
#pragma unroll
        for (int i = 0; i < 64; ++i) vnT[(64 * q + i) * LP + s] = (bf16)f2bf((x[i] - mu) * rstd * gp[i]);
    }
    const int et = tid >> 2, edq = tid & 3;
    for (int hh = 0; hh < 4; ++hh) {
        LDS_BARRIER();
        const bf16* sup = PROJ + (row0 + et) * NPROJ + C_SU + hh * 64 + 16 * edq;
        const v4u su0 = *(const v4u*)sup, su1 = *(const v4u*)(sup + 8);
        {   const int t = wt, sq = wsq;
#pragma unroll
            for (int c8 = 0; c8 < 4; ++c8) { const f32x4 a = wa[c8], c = wc[c8]; float f[8] = {a[0], a[1], a[2], a[3], c[0], c[1], c[2], c[3]};
#pragma unroll
                for (int i = 0; i < 8; ++i) if (sq + 8 * c8 + i > t) f[i] = 0.f;
                v4u o; o.x = pk2(f[0], f[1]); o.y = pk2(f[2], f[3]); o.z = pk2(f[4], f[5]); o.w = pk2(f[6], f[7]);
                *(LAS v4u*)(Wb + t * LP + sq + 8 * c8) = o; }
            if (hh < 3) { const float* wsrc = KARG(11) + ((size_t)(layer * 4 + hh + 1) * 128 + wt) * 128 + wsq;
#pragma unroll
                for (int c8 = 0; c8 < 4; ++c8) { wa[c8] = *(const f32x4*)(wsrc + 8 * c8); wc[c8] = *(const f32x4*)(wsrc + 8 * c8 + 4); } } }
        LDS_BARRIER();
        f32x4 acc[4];
#pragma unroll
        for (int nt = 0; nt < 4; ++nt) acc[nt] = (f32x4){0.f, 0.f, 0.f, 0.f};
        for (int ks = 0; ks < 4; ++ks) { if (32 * ks > 16 * w + 15) break;
            const bf16x8 a = *(const LAS bf16x8*)(Wb + (16 * w + (lane & 15)) * LP + 32 * ks + 8 * (lane >> 4));
#pragma unroll
            for (int nt = 0; nt < 4; ++nt) { const bf16x8 bb = *(const LAS bf16x8*)(vnT + (hh * 64 + 16 * nt + (lane & 15)) * LP + 32 * ks + 8 * (lane >> 4));
                acc[nt] = __builtin_amdgcn_mfma_f32_16x16x32_bf16(a, bb, acc[nt], 0, 0, 0); } }
        const float* sb = KARG(12) + (size_t)(layer * 4 + hh) * 128 + 16 * w + 4 * (lane >> 4);
        const f32x4 sb4 = *(const f32x4*)sb;
#pragma unroll
        for (int nt = 0; nt < 4; ++nt)
#pragma unroll
            for (int r = 0; r < 4; ++r) OT[(16 * w + 4 * (lane >> 4) + r) * OP + 16 * nt + (lane & 15)] = (bf16)f2bf(acc[nt][r] + sb4[r]);
        LDS_BARRIER();
        {   const v4u m0 = *(const LAS v4u*)(OT + et * OP + 16 * edq), m1 = *(const LAS v4u*)(OT + et * OP + 16 * edq + 8);
            v4u o0, o1;
            o0.x = pg8::cvt_pk_bf16(bflo(su0.x) * bflo(m0.x), bfhi(su0.x) * bfhi(m0.x)); o0.y = pg8::cvt_pk_bf16(bflo(su0.y) * bflo(m0.y), bfhi(su0.y) * bfhi(m0.y));
            o0.z = pg8::cvt_pk_bf16(bflo(su0.z) * bflo(m0.z), bfhi(su0.z) * bfhi(m0.z)); o0.w = pg8::cvt_pk_bf16(bflo(su0.w) * bflo(m0.w), bfhi(su0.w) * bfhi(m0.w));
            o1.x = pg8::cvt_pk_bf16(bflo(su1.x) * bflo(m1.x), bfhi(su1.x) * bfhi(m1.x)); o1.y = pg8::cvt_pk_bf16(bflo(su1.y) * bflo(m1.y), bfhi(su1.y) * bfhi(m1.y));
            o1.z = pg8::cvt_pk_bf16(bflo(su1.z) * bflo(m1.z), bfhi(su1.z) * bfhi(m1.z)); o1.w = pg8::cvt_pk_bf16(bflo(su1.w) * bflo(m1.w), bfhi(su1.w) * bfhi(m1.w));
            bf16* mp = MIX + (row0 + et) * DM + 256 + hh * 64 + 16 * edq;
            *(v4u*)mp = o0; *(v4u*)(mp + 8) = o1; }
    }
}

typedef short v4i16_t __attribute__((ext_vector_type(4)));
constexpr int RM_PB = 144;
constexpr int RM_QD = 0, RM_KD = 18432, RM_QB = 36864, RM_KU = 55296, RM_V = 73728, RM_DEC = 92160, RM_O = 94208, RM_OP = 68;
static_assert(RM_O + 128 * RM_OP * 4 <= RING_BYTES, "recurrence LDS map");
__device__ __forceinline__ bf16x8 mk_frag(unsigned a, unsigned b, unsigned c, unsigned d) { return __builtin_bit_cast(bf16x8, (v4u){a, b, c, d}); }
template <bool GLA>
__device__ __forceinline__ void recur_mfma(Frame& F, int layer, int b, int hh) {
    constexpr int KD = GLA ? 32 : 64, NKT = KD / 16, NKS = KD / 32;
    LAS unsigned char* L = F.lds + RING_OFF;
    const bf16* PROJ = (const bf16*)(F.ws + WS_PROJ); bf16* MIX = (bf16*)(F.ws + WS_MIX);
    const int tid = F.tid, lane = F.lane, w = F.wave;
    const int li = lane & 15, kq = lane >> 4;
    float lbk = 0.f, bgk = 0.f;
    const int pk = GLA ? (lane & 31) : lane, phalf = GLA ? (lane >> 5) : 0;
    if (!GLA) lbk = ((const float*)(F.ws + WS_LB))[layer * 256 + hh * 64 + pk];
    else bgk = KARG(14)[layer * 128 + hh * 32 + pk];
    const int etok = tid >> 2, eq = tid & 3;
    const float* cwp = KARG(9) + layer * 768;
    f32x4 ng[4];
    { const float* ngp = (GLA ? KARG(15) : KARG(17)) + layer * 64 + 16 * eq;
#pragma unroll
      for (int i = 0; i < 4; ++i) ng[i] = *(const f32x4*)(ngp + 4 * i); }
    f32x4 S[NKT];
#pragma unroll
    for (int kt = 0; kt < NKT; ++kt) S[kt] = (f32x4){0.f, 0.f, 0.f, 0.f};
    const int hb = GLA ? C_GLA + GLA_W * hh : C_HGR + HGR_W * hh, c_q = hb, c_k = hb + (GLA ? 32 : 64), c_v = hb + (GLA ? 64 : 128), c_g = hb + (GLA ? 128 : 192), c_z = hb + 192;
    __syncthreads();
    constexpr int NJ = GLA ? 8 : 16;
    const int trow = 16 * w + 8 * phalf;
    const int vr = tid >> 2, vp = tid & 3;
    constexpr int NQ = GLA ? 1 : 2, PSH = GLA ? 2 : 3;
    v4u qa[NQ], ka[NQ], za, va0, va1, gn0, gn1, gc0, gc1; za = (v4u){0u, 0u, 0u, 0u};
#define RM_LOAD_RAW(T0) do { const size_t rb_ = (size_t)b * SEQ + (T0); \
        _Pragma("unroll") for (int i_ = 0; i_ < NQ; ++i_) { const int p_ = tid + 512 * i_, row_ = p_ >> PSH, pc_ = p_ & ((1 << PSH) - 1); const bf16* s_ = PROJ + (rb_ + row_) * NPROJ + 8 * pc_; \
            qa[i_] = *(const v4u*)(s_ + c_q); ka[i_] = *(const v4u*)(s_ + c_k); if (GLA) za = *(const v4u*)(s_ + c_z); } \
        { const bf16* s_ = PROJ + (rb_ + vr) * NPROJ + c_v + 16 * vp; va0 = *(const v4u*)s_; va1 = *(const v4u*)(s_ + 8); } \
        { const bf16* g_ = PROJ + (rb_ + etok) * NPROJ + c_g + 16 * eq; gn0 = *(const v4u*)g_; gn1 = *(const v4u*)(g_ + 8); } } while (0)
    RM_LOAD_RAW(0);
    asm volatile("" ::: "memory");
    for (int t0 = 0; t0 < SEQ; t0 += 128) {
        const size_t rowbase = (size_t)b * SEQ + t0;
        *(LAS v4u*)(L + RM_V + vr * RM_PB + vp * 32) = va0; *(LAS v4u*)(L + RM_V + vr * RM_PB + vp * 32 + 16) = va1;
#pragma unroll
        for (int i = 0; i < NQ; ++i) { const int p = tid + 512 * i, row = p >> PSH, pc = p & ((1 << PSH) - 1);
            *(LAS v4u*)(L + RM_QD + row * RM_PB + pc * 16) = qa[i]; *(LAS v4u*)(L + RM_KD + row * RM_PB + pc * 16) = ka[i]; if (GLA) *(LAS v4u*)(L + RM_QB + row * RM_PB + pc * 16) = za; }
        gc0 = gn0; gc1 = gn1;
        if (t0 + 128 < SEQ) { RM_LOAD_RAW(t0 + 128); }
        asm volatile("" ::: "memory");
        LDS_BARRIER();
        float qv[NJ], kv[NJ], bb[NJ];
        {   const LAS bf16* rq = (const LAS bf16*)(L + RM_QD + trow * RM_PB) + pk; const LAS bf16* rk = (const LAS bf16*)(L + RM_KD + trow * RM_PB) + pk; const LAS bf16* rz = (const LAS bf16*)(L + RM_QB + trow * RM_PB) + pk;
            unsigned short qr[NJ], kr[NJ], zr[GLA ? NJ : 1];
#pragma unroll
            for (int j = 0; j < NJ; ++j) { qr[j] = rq[j * (RM_PB / 2)]; kr[j] = rk[j * (RM_PB / 2)]; if (GLA) zr[j] = rz[j * (RM_PB / 2)]; }
#pragma unroll
            for (int j = 0; j < NJ; ++j) {
                if (!GLA) { qv[j] = bflo((unsigned)qr[j]); const float fl = bflo((unsigned)kr[j]);
                    const float f = fmaxf(lbk + (1.0f - lbk) * sigmoid_f(fl), 1e-30f); kv[j] = 1.0f - f; bb[j] = __logf(f); }
                else { qv[j] = bflo((unsigned)qr[j]) * 0.17677669529663687f; kv[j] = bflo((unsigned)kr[j]);
                    bb[j] = logsigmoid_f(bflo((unsigned)zr[GLA ? j : 0]) + bgk) * 0.0625f; }
            }
        }
#pragma unroll
        for (int j = 1; j < NJ; ++j) bb[j] += bb[j - 1];
        float bref, blast;
        if (!GLA) { bref = bb[8]; blast = bb[15]; }
        else { const float lowtot = __shfl_xor(bb[7], 32);
            if (phalf) {
#pragma unroll
                for (int j = 0; j < NJ; ++j) bb[j] += lowtot; }
            const float x0 = bb[0], y0 = __shfl_xor(x0, 32), x7 = bb[7], y7 = __shfl_xor(x7, 32);
            bref = phalf ? x0 : y0; blast = phalf ? x7 : y7; }
        {   const float E = __expf(bref), Gm = __expf(blast - bref);
            LAS bf16* qd = (LAS bf16*)(L + RM_QD + trow * RM_PB) + pk; LAS bf16* kd = (LAS bf16*)(L + RM_KD + trow * RM_PB) + pk;
            LAS bf16* qb = (LAS bf16*)(L + RM_QB + trow * RM_PB) + pk; LAS bf16* ku = (LAS bf16*)(L + RM_KU + trow * RM_PB) + pk;
#pragma unroll
            for (int j = 0; j < NJ; ++j) { const float e1 = __expf(bb[j] - bref), r1 = __builtin_amdgcn_rcpf(e1), a = qv[j] * e1, c = kv[j] * r1;
                const unsigned pa = pg8::cvt_pk_bf16(a, a * E), pc = pg8::cvt_pk_bf16(c, c * Gm);
                qd[j * (RM_PB / 2)] = (bf16)(pa & 0xffffu); qb[j * (RM_PB / 2)] = (bf16)(pa >> 16); kd[j * (RM_PB / 2)] = (bf16)(pc & 0xffffu); ku[j * (RM_PB / 2)] = (bf16)(pc >> 16); }
            if (phalf == 0) ((LAS float*)(L + RM_DEC))[w * 64 + pk] = __expf(blast);
        }
        LDS_BARRIER();
        if (w < 4) {
            const int v0 = 16 * w;
            const int q4 = li >> 2, p4 = li & 3;
#pragma unroll 2
            for (int c = 0; c < 8; ++c) {
                const int r0 = 16 * c;
                f32x4 pt = (f32x4){0.f, 0.f, 0.f, 0.f};
#pragma unroll
                for (int s = 0; s < NKS; ++s) { const bf16x8 a = *(const LAS bf16x8*)(L + RM_KD + (r0 + li) * RM_PB + (32 * s + 8 * kq) * 2), bq = *(const LAS bf16x8*)(L + RM_QD + (r0 + li) * RM_PB + (32 * s + 8 * kq) * 2);
                    pt = __builtin_amdgcn_mfma_f32_16x16x32_bf16(a, bq, pt, 0, 0, 0); }
#pragma unroll
                for (int r = 0; r < 4; ++r) if (4 * kq + r > li) pt[r] = 0.f;
                const bf16x8 pfrag = mk_frag(pg8::cvt_pk_bf16(pt[0], pt[1]), pg8::cvt_pk_bf16(pt[2], pt[3]), 0u, 0u);
                const v4i16_t tv = __builtin_amdgcn_ds_read_tr16_b64_v4i16((LAS v4i16_t*)(L + RM_V + (r0 + 4 * kq + q4) * RM_PB + (v0 + 4 * p4) * 2));
                const u32x2 tv2 = __builtin_bit_cast(u32x2, tv);
                const bf16x8 vfrag = mk_frag(tv2.x, tv2.y, 0u, 0u);
                f32x4 o = __builtin_amdgcn_mfma_f32_16x16x32_bf16(pfrag, vfrag, (f32x4){0.f, 0.f, 0.f, 0.f}, 0, 0, 0);
#pragma unroll
                for (int s = 0; s < NKS; ++s) { const LAS unsigned char* qp = L + RM_QB + (r0 + li) * RM_PB + (32 * s + 4 * kq) * 2; const u32x2 lo = *(const LAS u32x2*)qp, hi = *(const LAS u32x2*)(qp + 32);
                    const bf16x8 a = mk_frag(lo.x, lo.y, hi.x, hi.y);
                    const bf16x8 sb = mk_frag(pg8::cvt_pk_bf16(S[2 * s][0], S[2 * s][1]), pg8::cvt_pk_bf16(S[2 * s][2], S[2 * s][3]), pg8::cvt_pk_bf16(S[2 * s + 1][0], S[2 * s + 1][1]), pg8::cvt_pk_bf16(S[2 * s + 1][2], S[2 * s + 1][3]));
                    o = __builtin_amdgcn_mfma_f32_16x16x32_bf16(a, sb, o, 0, 0, 0); }
#pragma unroll
                for (int kt = 0; kt < NKT; ++kt) { const v4i16_t tk = __builtin_amdgcn_ds_read_tr16_b64_v4i16((LAS v4i16_t*)(L + RM_KU + (r0 + 4 * kq + q4) * RM_PB + (16 * kt + 4 * p4) * 2));
                    const u32x2 tk2 = __builtin_bit_cast(u32x2, tk); const bf16x8 a = mk_frag(tk2.x, tk2.y, 0u, 0u);
                    const f32x4 d4 = *(const LAS f32x4*)(L + RM_DEC + (c * 64 + 16 * kt + 4 * kq) * 4);
                    S[kt] = __builtin_amdgcn_mfma_f32_16x16x32_bf16(a, vfrag, S[kt] * d4, 0, 0, 0); }
                LAS float* op = (LAS float*)(L + RM_O) + (r0 + 4 * kq) * RM_OP + v0 + li;
#pragma unroll
                for (int r = 0; r < 4; ++r) op[r * RM_OP] = o[r];
            }
        }
        else if (F.G == 256) {
            const int i0 = F.vcu * 8192 + (t0 >> 7) * 512 + (tid - 256);
            conv_item(PROJ, MIX, cwp, i0); conv_item(PROJ, MIX, cwp, i0 + 256);
        }
        LDS_BARRIER();
        {   const LAS float* op = (const LAS float*)(L + RM_O) + etok * RM_OP + 16 * eq;
            f32x4 ov[4]; float ss = 0.f;
#pragma unroll
            for (int i = 0; i < 4; ++i) { ov[i] = *(const LAS f32x4*)(op + 4 * i); ss += (ov[i][0] * ov[i][0] + ov[i][1] * ov[i][1]) + (ov[i][2] * ov[i][2] + ov[i][3] * ov[i][3]); }
            ss += __shfl_xor(ss, 1); ss += __shfl_xor(ss, 2);
            const float rstd = rsqrtf(ss * (1.0f / 64.0f) + EPS);
            const v4u g0 = gc0, g1 = gc1;
            const float gt[16] = {bflo(g0.x), bfhi(g0.x), bflo(g0.y), bfhi(g0.y), bflo(g0.z), bfhi(g0.z), bflo(g0.w), bfhi(g0.w), bflo(g1.x), bfhi(g1.x), bflo(g1.y), bfhi(g1.y), bflo(g1.z), bfhi(g1.z), bflo(g1.w), bfhi(g1.w)};
            float y[16];
#pragma unroll
            for (int i = 0; i < 16; ++i) y[i] = ov[i >> 2][i & 3] * rstd * ng[i >> 2][i & 3] * silu_f(gt[i]);
            v4u o0, o1; o0.x = pg8::cvt_pk_bf16(y[0], y[1]); o0.y = pg8::cvt_pk_bf16(y[2], y[3]); o0.z = pg8::cvt_pk_bf16(y[4], y[5]); o0.w = pg8::cvt_pk_bf16(y[6], y[7]);
            o1.x = pg8::cvt_pk_bf16(y[8], y[9]); o1.y = pg8::cvt_pk_bf16(y[10], y[11]); o1.z = pg8::cvt_pk_bf16(y[12], y[13]); o1.w = pg8::cvt_pk_bf16(y[14], y[15]);
            bf16* mp = MIX + (rowbase + etok) * DM + (GLA ? 512 : 768) + hh * 64 + 16 * eq;
            *(v4u*)mp = o0; *(v4u*)(mp + 8) = o1;
        }
    }
#undef RM_LOAD_RAW
    __syncthreads();
}
constexpr int RP_SET = 5 * 64 * RM_PB;
constexpr int RP_QD = 0, RP_KD = 64 * RM_PB, RP_QB = 2 * 64 * RM_PB, RP_KU = 3 * 64 * RM_PB, RP_V = 4 * 64 * RM_PB, RP_DEC = 2 * RP_SET, RP_O = RP_DEC + 2 * 4 * 64 * 4, RP_OSZ = 64 * RM_OP * 4;
static_assert(RP_O + 2 * RP_OSZ <= RING_BYTES, "recurrence LDS map");
static_assert(RP_O + 64 * RM_OP * 4 <= RING_BYTES, "pipelined recurrence LDS map");
template <bool GLA>
__device__ __forceinline__ void recur_pipe(Frame& F, int layer, int b, int hh, int var = 0) {
    constexpr int KD = GLA ? 32 : 64, NKT = KD / 16, NKS = KD / 32, NBLK = SEQ / 64;
    LAS unsigned char* L = F.lds + RING_OFF;
    const bf16* PROJ = (const bf16*)(F.ws + WS_PROJ); bf16* MIX = (bf16*)(F.ws + WS_MIX);
    const int tid = F.tid, lane = F.lane, w = F.wave;
    const bool prod = w >= 4; const int pw = w & 3, ptid = tid & 255;
    const int li = lane & 15, kq = lane >> 4;
    const int hb = GLA ? C_GLA + GLA_W * hh : C_HGR + HGR_W * hh, c_q = hb, c_k = hb + (GLA ? 32 : 64), c_v = hb + (GLA ? 64 : 128), c_g = hb + (GLA ? 128 : 192), c_z = hb + 192;
    const size_t seq0 = (size_t)b * SEQ;
    __syncthreads();
    if (prod) {
        float lbk = 0.f, bgk = 0.f;
        const int pk = GLA ? (lane & 31) : lane, phalf = GLA ? (lane >> 5) : 0;
        if (!GLA) lbk = ((const float*)(F.ws + WS_LB))[layer * 256 + hh * 64 + pk]; else bgk = KARG(14)[layer * 128 + hh * 32 + pk];
        constexpr int NJ = GLA ? 8 : 16, NQ = GLA ? 1 : 2, PSH = GLA ? 2 : 3;
        const int trow = 16 * pw + 8 * phalf;
        v4u qa[2][NQ], ka[2][NQ], za[2], va[2][2]; za[0] = (v4u){0u, 0u, 0u, 0u}; za[1] = za[0];
#define RP_LOAD(N, RS) do { const size_t rb_ = seq0 + (size_t)(N) * 64; \
            _Pragma("unroll") for (int i_ = 0; i_ < NQ; ++i_) { const int row_ = 16 * pw + 8 * i_ + (lane >> PSH), pc_ = lane & ((1 << PSH) - 1); const bf16* s_ = PROJ + (rb_ + row_) * NPROJ + 8 * pc_; \
                qa[RS][i_] = *(const v4u*)(s_ + c_q); ka[RS][i_] = *(const v4u*)(s_ + c_k); if (GLA) za[RS] = *(const v4u*)(s_ + c_z); } \
            _Pragma("unroll") for (int i_ = 0; i_ < 2; ++i_) { const int p_ = ptid + 256 * i_; va[RS][i_] = *(const v4u*)(PROJ + (rb_ + (p_ >> 3)) * NPROJ + c_v + 8 * (p_ & 7)); } } while (0)
#define RP_STAGE(SET, RS) do { LAS unsigned char* B_ = L + (SET) * RP_SET; \
            _Pragma("unroll") for (int i_ = 0; i_ < NQ; ++i_) { const int row_ = 16 * pw + 8 * i_ + (lane >> PSH), pc_ = lane & ((1 << PSH) - 1); \
                *(LAS v4u*)(B_ + RP_QD + row_ * RM_PB + pc_ * 16) = qa[RS][i_]; *(LAS v4u*)(B_ + RP_KD + row_ * RM_PB + pc_ * 16) = ka[RS][i_]; if (GLA) *(LAS v4u*)(B_ + RP_QB + row_ * RM_PB + pc_ * 16) = za[RS]; } \
            _Pragma("unroll") for (int i_ = 0; i_ < 2; ++i_) { const int p_ = ptid + 256 * i_; *(LAS v4u*)(B_ + RP_V + (p_ >> 3) * RM_PB + (p_ & 7) * 16) = va[RS][i_]; } } while (0)
#define RP_PREP(SET) do { LAS unsigned char* B_ = L + (SET) * RP_SET; \
            const LAS bf16* rq = (const LAS bf16*)(B_ + RP_QD + trow * RM_PB) + pk; const LAS bf16* rk = (const LAS bf16*)(B_ + RP_KD + trow * RM_PB) + pk; const LAS bf16* rz = (const LAS bf16*)(B_ + RP_QB + trow * RM_PB) + pk; \
            unsigned short qr[NJ], kr[NJ], zr[GLA ? NJ : 1]; float qv[NJ], kv[NJ], bb[NJ]; \
            _Pragma("unroll") for (int j = 0; j < NJ; ++j) { qr[j] = rq[j * (RM_PB / 2)]; kr[j] = rk[j * (RM_PB / 2)]; if (GLA) zr[j] = rz[j * (RM_PB / 2)]; } \
            _Pragma("unroll") for (int j = 0; j < NJ; ++j) { \
                if (!GLA) { qv[j] = bflo((unsigned)qr[j]); const float fl = bflo((unsigned)kr[j]); const float f = fmaxf(lbk + (1.0f - lbk) * sigmoid_f(fl), 1e-30f); kv[j] = 1.0f - f; bb[j] = __logf(f); } \
                else { qv[j] = bflo((unsigned)qr[j]) * 0.17677669529663687f; kv[j] = bflo((unsigned)kr[j]); bb[j] = logsigmoid_f(bflo((unsigned)zr[GLA ? j : 0]) + bgk) * 0.0625f; } } \
            _Pragma("unroll") for (int j = 1; j < NJ; ++j) bb[j] += bb[j - 1]; \
            float bref, blast; \
            if (!GLA) { bref = bb[GLA ? 0 : 8]; blast = bb[GLA ? 0 : 15]; } \
            else { const float lowtot = __shfl_xor(bb[7], 32); if (phalf) { _Pragma("unroll") for (int j = 0; j < NJ; ++j) bb[j] += lowtot; } \
                const float x0 = bb[0], y0 = __shfl_xor(x0, 32), x7 = bb[7], y7 = __shfl_xor(x7, 32); bref = phalf ? x0 : y0; blast = phalf ? x7 : y7; } \
            const float E = __expf(bref), Gm = __expf(blast - bref); \
            LAS bf16* qd = (LAS bf16*)(B_ + RP_QD + trow * RM_PB) + pk; LAS bf16* kd = (LAS bf16*)(B_ + RP_KD + trow * RM_PB) + pk; LAS bf16* qb = (LAS bf16*)(B_ + RP_QB + trow * RM_PB) + pk; LAS bf16* ku = (LAS bf16*)(B_ + RP_KU + trow * RM_PB) + pk; \
            _Pragma("unroll") for (int j = 0; j < NJ; ++j) { const float e1 = __expf(bb[j] - bref), r1 = __builtin_amdgcn_rcpf(e1), a = qv[j] * e1, c = kv[j] * r1; \
                const unsigned pa = pg8::cvt_pk_bf16(a, a * E), pc = pg8::cvt_pk_bf16(c, c * Gm); \
                qd[j * (RM_PB / 2)] = (bf16)(pa & 0xffffu); qb[j * (RM_PB / 2)] = (bf16)(pa >> 16); kd[j * (RM_PB / 2)] = (bf16)(pc & 0xffffu); ku[j * (RM_PB / 2)] = (bf16)(pc >> 16); } \
            if (phalf == 0) ((LAS float*)(L + RP_DEC))[((SET) * 4 + pw) * 64 + pk] = __expf(blast); } while (0)
        RP_LOAD(0, 0); RP_LOAD(1, 1); asm volatile("" ::: "memory");
        RP_STAGE(0, 0); RP_LOAD(2, 0); asm volatile("" ::: "memory");
        RP_PREP(0);
        LDS_BARRIER();
        for (int n = 0; n < NBLK; n += 2) {
            { RP_STAGE(1, 1); if (n + 3 < NBLK) { RP_LOAD(n + 3, 1); } asm volatile("" ::: "memory"); if (var != 2 && var != 5) { RP_PREP(1); } }
            LDS_BARRIER();
            if (n + 2 < NBLK) { RP_STAGE(0, 0); if (n + 4 < NBLK) { RP_LOAD(n + 4, 0); } asm volatile("" ::: "memory"); if (var != 2 && var != 5) { RP_PREP(0); } }
            LDS_BARRIER();
        }
#undef RP_LOAD
#undef RP_STAGE
#undef RP_PREP
    } else {
        const int etok = ptid >> 2, eq = ptid & 3;
        const float* cwp = KARG(9) + layer * 768;
        f32x4 ng[4];
        { const float* ngp = (GLA ? KARG(15) : KARG(17)) + layer * 64 + 16 * eq;
#pragma unroll
          for (int i = 0; i < 4; ++i) ng[i] = *(const f32x4*)(ngp + 4 * i); }
        f32x4 S[NKT];
#pragma unroll
        for (int kt = 0; kt < NKT; ++kt) S[kt] = (f32x4){0.f, 0.f, 0.f, 0.f};
        const int v0 = 16 * pw, q4 = li >> 2, p4 = li & 3;
        v4u gn0, gn1;
        { const bf16* g_ = PROJ + (seq0 + etok) * NPROJ + c_g + 16 * eq; gn0 = *(const v4u*)g_; gn1 = *(const v4u*)(g_ + 8); }
        const bool do_conv = (F.G == 256) && var != 1 && var != 5;
        const int cc8 = (ptid & 31) * 8;
        LAS float* cwl = (LAS float*)(F.lds + ROWTAB_OFF);
#pragma unroll
        for (int d_ = 0; d_ < 3; ++d_) cwl[d_ * 256 + ptid] = cwp[d_ * 256 + ptid];
        v4u craw[7];
        asm volatile("" ::: "memory");
        LDS_BARRIER();
        for (int n = 0; n <= NBLK; ++n) {
            if (n < NBLK) {
            if (do_conv) { const int t_ = (F.vcu * 8192 + n * 256 + ptid) >> 5, tin_ = t_ & (SEQ - 1); const bf16* pr_ = PROJ + (size_t)t_ * NPROJ + cc8;
#pragma unroll
                for (int d_ = 0; d_ < 3; ++d_) { if (tin_ >= d_) { craw[2 * d_] = *(const v4u*)(pr_ - (size_t)d_ * NPROJ + C_CC); craw[2 * d_ + 1] = *(const v4u*)(pr_ - (size_t)d_ * NPROJ + C_CX); } else { craw[2 * d_] = (v4u){0u, 0u, 0u, 0u}; craw[2 * d_ + 1] = (v4u){0u, 0u, 0u, 0u}; } }
                craw[6] = *(const v4u*)(pr_ + C_CB); }
            const LAS unsigned char* B = L + (n & 1) * RP_SET;
            if (var != 3 && var != 5) {
            f32x4 oi[4]; bf16x8 vf[4];
#pragma unroll
            for (int c = 0; c < 4; ++c) {
                const int r0 = 16 * c;
                f32x4 pt = (f32x4){0.f, 0.f, 0.f, 0.f};
#pragma unroll
                for (int s = 0; s < NKS; ++s) { const bf16x8 a = *(const LAS bf16x8*)(B + RP_KD + (r0 + li) * RM_PB + (32 * s + 8 * kq) * 2), bq = *(const LAS bf16x8*)(B + RP_QD + (r0 + li) * RM_PB + (32 * s + 8 * kq) * 2);
                    pt = __builtin_amdgcn_mfma_f32_16x16x32_bf16(a, bq, pt, 0, 0, 0); }
#pragma unroll
                for (int r = 0; r < 4; ++r) if (4 * kq + r > li) pt[r] = 0.f;
                const bf16x8 pfrag = mk_frag(pg8::cvt_pk_bf16(pt[0], pt[1]), pg8::cvt_pk_bf16(pt[2], pt[3]), 0u, 0u);
                const v4i16_t tv = __builtin_amdgcn_ds_read_tr16_b64_v4i16((LAS v4i16_t*)(B + RP_V + (r0 + 4 * kq + q4) * RM_PB + (v0 + 4 * p4) * 2));
                const u32x2 tv2 = __builtin_bit_cast(u32x2, tv);
                vf[c] = mk_frag(tv2.x, tv2.y, 0u, 0u);
                oi[c] = __builtin_amdgcn_mfma_f32_16x16x32_bf16(pfrag, vf[c], (f32x4){0.f, 0.f, 0.f, 0.f}, 0, 0, 0);
            }
#pragma unroll
            for (int c = 0; c < 4; ++c) {
                const int r0 = 16 * c;
                f32x4 o = oi[c];
#pragma unroll
                for (int s = 0; s < NKS; ++s) { const LAS unsigned char* qp = B + RP_QB + (r0 + li) * RM_PB + (32 * s + 4 * kq) * 2; const u32x2 lo = *(const LAS u32x2*)qp, hi = *(const LAS u32x2*)(qp + 32);
                    const bf16x8 a = mk_frag(lo.x, lo.y, hi.x, hi.y);
                    const bf16x8 sb = mk_frag(pg8::cvt_pk_bf16(S[2 * s][0], S[2 * s][1]), pg8::cvt_pk_bf16(S[2 * s][2], S[2 * s][3]), pg8::cvt_pk_bf16(S[2 * s + 1][0], S[2 * s + 1][1]), pg8::cvt_pk_bf16(S[2 * s + 1][2], S[2 * s + 1][3]));
                    o = __builtin_amdgcn_mfma_f32_16x16x32_bf16(a, sb, o, 0, 0, 0); }
#pragma unroll
                for (int kt = 0; kt < NKT; ++kt) { const v4i16_t tk = __builtin_amdgcn_ds_read_tr16_b64_v4i16((LAS v4i16_t*)(B + RP_KU + (r0 + 4 * kq + q4) * RM_PB + (16 * kt + 4 * p4) * 2));
                    const u32x2 tk2 = __builtin_bit_cast(u32x2, tk); const bf16x8 a = mk_frag(tk2.x, tk2.y, 0u, 0u);
                    const f32x4 d4 = *(const LAS f32x4*)(L + RP_DEC + (((n & 1) * 4 + c) * 64 + 16 * kt + 4 * kq) * 4);
                    S[kt] = __builtin_amdgcn_mfma_f32_16x16x32_bf16(a, vf[c], S[kt] * d4, 0, 0, 0); }
                oi[c] = o;
            }
#pragma unroll
            for (int c = 0; c < 4; ++c) { LAS float* op = (LAS float*)(L + RP_O + (n & 1) * RP_OSZ) + (16 * c + 4 * kq) * RM_OP + v0 + li;
#pragma unroll
                for (int r = 0; r < 4; ++r) op[r * RM_OP] = oi[c][r]; }
            }
            }
            const v4u g0 = gn0, g1 = gn1;
            if (n < NBLK && n > 0) { const bf16* g_ = PROJ + (seq0 + (size_t)n * 64 + etok) * NPROJ + c_g + 16 * eq; gn0 = *(const v4u*)g_; gn1 = *(const v4u*)(g_ + 8); }
            asm volatile("" ::: "memory");
            if (n > 0 && var != 4 && var != 5) {   const LAS float* op = (const LAS float*)(L + RP_O + ((n - 1) & 1) * RP_OSZ) + etok * RM_OP + 16 * eq;
                f32x4 ov[4]; float ss = 0.f;
#pragma unroll
                for (int i = 0; i < 4; ++i) { ov[i] = *(const LAS f32x4*)(op + 4 * i); ss += (ov[i][0] * ov[i][0] + ov[i][1] * ov[i][1]) + (ov[i][2] * ov[i][2] + ov[i][3] * ov[i][3]); }
                ss += __shfl_xor(ss, 1); ss += __shfl_xor(ss, 2);
                const float rstd = rsqrtf(ss * (1.0f / 64.0f) + EPS);
                const float gt[16] = {bflo(g0.x), bfhi(g0.x), bflo(g0.y), bfhi(g0.y), bflo(g0.z), bfhi(g0.z), bflo(g0.w), bfhi(g0.w), bflo(g1.x), bfhi(g1.x), bflo(g1.y), bfhi(g1.y), bflo(g1.z), bfhi(g1.z), bflo(g1.w), bfhi(g1.w)};
                float y[16];
#pragma unroll
                for (int i = 0; i < 16; ++i) y[i] = ov[i >> 2][i & 3] * rstd * ng[i >> 2][i & 3] * silu_f(gt[i]);
                v4u o0, o1; o0.x = pg8::cvt_pk_bf16(y[0], y[1]); o0.y = pg8::cvt_pk_bf16(y[2], y[3]); o0.z = pg8::cvt_pk_bf16(y[4], y[5]); o0.w = pg8::cvt_pk_bf16(y[6], y[7]);
                o1.x = pg8::cvt_pk_bf16(y[8], y[9]); o1.y = pg8::cvt_pk_bf16(y[10], y[11]); o1.z = pg8::cvt_pk_bf16(y[12], y[13]); o1.w = pg8::cvt_pk_bf16(y[14], y[15]);
                bf16* mp = MIX + (seq0 + (size_t)(n - 1) * 64 + etok) * DM + (GLA ? 512 : 768) + hh * 64 + 16 * eq;
                *(v4u*)mp = o0; *(v4u*)(mp + 8) = o1; }
            if (n < NBLK) {
                if (do_conv) { const int t_ = (F.vcu * 8192 + n * 256 + ptid) >> 5;
                    float y[8]; float cwr[3][8];
#pragma unroll
                    for (int d_ = 0; d_ < 3; ++d_) { const f32x4 c0 = *(const LAS f32x4*)(cwl + d_ * 256 + cc8), c1 = *(const LAS f32x4*)(cwl + d_ * 256 + cc8 + 4);
#pragma unroll
                        for (int i = 0; i < 4; ++i) { cwr[d_][i] = c0[i]; cwr[d_][4 + i] = c1[i]; } }
#pragma unroll
                    for (int i = 0; i < 8; ++i) { const int w_ = i >> 1;
                        const float z0 = (i & 1) ? bfhi(craw[0][w_]) * bfhi(craw[1][w_]) : bflo(craw[0][w_]) * bflo(craw[1][w_]);
                        const float z1 = (i & 1) ? bfhi(craw[2][w_]) * bfhi(craw[3][w_]) : bflo(craw[2][w_]) * bflo(craw[3][w_]);
                        const float z2 = (i & 1) ? bfhi(craw[4][w_]) * bfhi(craw[5][w_]) : bflo(craw[4][w_]) * bflo(craw[5][w_]);
                        const float bb = (i & 1) ? bfhi(craw[6][w_]) : bflo(craw[6][w_]);
                        y[i] = bb * (cwr[0][i] * z2 + cwr[1][i] * z1 + cwr[2][i] * z0); }
                    v4u o; o.x = pg8::cvt_pk_bf16(y[0], y[1]); o.y = pg8::cvt_pk_bf16(y[2], y[3]); o.z = pg8::cvt_pk_bf16(y[4], y[5]); o.w = pg8::cvt_pk_bf16(y[6], y[7]);
                    *(v4u*)(MIX + (size_t)t_ * DM + cc8) = o; }
                LDS_BARRIER();
            }
        }
    }
    __syncthreads();
}
#ifndef DUP_REC
#define DUP_REC 1
#endif
#ifndef DUP_SGU
#define DUP_SGU 1
#endif
#ifndef DUP_CONV
#define DUP_CONV 1
#endif
__device__ __forceinline__ void mixer_phase(Frame& F, int layer) {
#pragma unroll 1
    for (int rep = 0; rep < DUP_REC; ++rep)
    for (int u = F.vcu; u < 256; u += F.G) { const int bh = u >> 1, b = bh >> 2, hh = bh & 3;
#ifdef DUP_REC_ONLY
        if (rep + 1 < DUP_REC && (u & 1) != DUP_REC_ONLY) continue;
#endif
#ifdef REC_NOPIPE
        if (u & 1) recur_mfma<true>(F, layer, b, hh); else recur_mfma<false>(F, layer, b, hh); }
#else
        { int var = 0;
#ifdef REC_VAR
          if (rep + 1 < DUP_REC) var = REC_VAR;
#endif
          if (u & 1) recur_pipe<true>(F, layer, b, hh, var); else recur_pipe<false>(F, layer, b, hh, var); } }
#endif
#pragma unroll 1
    for (int rep = 0; rep < DUP_SGU; ++rep) {
        if (F.G == 256) {
            for (int i = 0; i < 2; ++i) { const int u = 2 * F.vcu + i; sgu_unit(F, layer, u >> 4, u & 15); }
        } else for (int u = F.vcu; u < NB * 16; u += F.G) sgu_unit(F, layer, u >> 4, u & 15);
    }
    if (F.G != 256) conv_phase(F, layer);
}


#ifndef DUP_P0
#define DUP_P0 1
#endif
#define EN_P0(x) do { _Pragma("unroll 1") for (int rep_ = 0; rep_ < DUP_P0; ++rep_) { x; } } while (0)
#ifndef DUP_NORM
#define DUP_NORM 1
#endif
#define EN_NORM(x) do { _Pragma("unroll 1") for (int rep_ = 0; rep_ < DUP_NORM; ++rep_) { x; } } while (0)
#ifndef DUP_NORM1
#define DUP_NORM1 1
#endif
#define EN_NORM1(x) do { _Pragma("unroll 1") for (int rep_ = 0; rep_ < DUP_NORM1; ++rep_) { x; } } while (0)
#ifndef DUP_MX
#define DUP_MX 1
#endif
#define EN_MX(x) do { _Pragma("unroll 1") for (int rep_ = 0; rep_ < DUP_MX; ++rep_) { x; } } while (0)
#ifndef DUP_FINAL
#define DUP_FINAL 1
#endif
#define EN_FINAL(x) do { _Pragma("unroll 1") for (int rep_ = 0; rep_ < DUP_FINAL; ++rep_) { x; } } while (0)
#ifndef DUP_G1
#define DUP_G1 1
#endif
#define EN_G1(x) do { _Pragma("unroll 1") for (int rep_ = 0; rep_ < DUP_G1; ++rep_) { x; } } while (0)
#ifndef DUP_G2
#define DUP_G2 1
#endif
#define EN_G2(x) do { _Pragma("unroll 1") for (int rep_ = 0; rep_ < DUP_G2; ++rep_) { x; } } while (0)
#ifndef DUP_G3
#define DUP_G3 1
#endif
#define EN_G3(x) do { _Pragma("unroll 1") for (int rep_ = 0; rep_ < DUP_G3; ++rep_) { x; } } while (0)
#ifndef DUP_G4
#define DUP_G4 1
#endif
#define EN_G4(x) do { _Pragma("unroll 1") for (int rep_ = 0; rep_ < DUP_G4; ++rep_) { x; } } while (0)
#ifndef DUP_UP
#define DUP_UP 1
#endif
#define EN_UP(x) do { _Pragma("unroll 1") for (int rep_ = 0; rep_ < DUP_UP; ++rep_) { x; } } while (0)
#ifndef DUP_DN
#define DUP_DN 1
#endif
#define EN_DN(x) do { _Pragma("unroll 1") for (int rep_ = 0; rep_ < DUP_DN; ++rep_) { x; } } while (0)
constexpr int N_STEPS = 1 + 4 * 5 + 2 * 2 + 2 * (1 + 1 + N_CHUNK) + 1;
struct Args { const float* in[25]; float* out; unsigned char* ws; int lo, hi; };
__global__ void __launch_bounds__(NWAVES * 64, 2) fwd_kernel(Args args) {
    extern __shared__ __attribute__((aligned(16))) unsigned char lds[];
    Frame F;
    F.lds = (LAS unsigned char*)lds; F.MISC = (volatile LAS unsigned*)(F.lds + LDSCTL_OFF);
    F.tid = threadIdx.x; F.lane = F.tid & 63; F.wave = __builtin_amdgcn_readfirstlane(F.tid >> 6);
    F.G = gridDim.x; { const int bx = blockIdx.x; F.vcu = (F.G % 8 == 0) ? (bx % 8) * (F.G / 8) + bx / 8 : bx; }
    F.ws = args.ws; F.ctl = (gu32*)(args.ws + WS_CTL); F.out = args.out;
    for (int u = F.tid; u < 256; u += NWAVES * 64) ((LAS unsigned*)(F.lds + LDSCTL_OFF))[u] = 0u;
    __syncthreads();
    const int lo = args.lo, hi = args.hi;
    XcdBarrier bar; bar.bar = (unsigned*)(F.ctl + CW_BAR); bar.x = 0; bar.st = nullptr;
    if (hi - lo > 1) bar = xcd_barrier_post((unsigned*)(F.ctl + CW_BAR), F.MISC + 8);
    int step = 0;
#define RUN_STEP(body) do { if (step >= lo && step < hi) { asm volatile("" : "+v"(F.tid)); asm volatile("" : "+v"(F.lane)); asm volatile("" : "+s"(F.wave)); asm volatile("" : "+s"(F.vcu));   body; if (step + 1 < hi) xcd_barrier(bar); } ++step; } while (0)
    LAS unsigned char* ring = F.lds + RING_OFF; LAS int* rowtab = (LAS int*)(F.lds + ROWTAB_OFF);
    unsigned char* ws = F.ws;
    const pg8::bf16_t* H = (const pg8::bf16_t*)(ws + WS_H); const pg8::bf16_t* MIXB = (const pg8::bf16_t*)(ws + WS_MIX);
    const float* MOD = (const float*)(ws + WS_MOD);

    RUN_STEP(EN_P0(p0_prologue(F)));
    for (int l = 0; l < DEPTH; ++l) {
        const float* modl = MOD + (size_t)l * 32 * NMOD; const float* modp = MOD + (size_t)(l > 0 ? l - 1 : 0) * 32 * NMOD;
        bf16* XB = (bf16*)F.out;
        bf16* XB2 = (bf16*)(ws + WS_XB2);
        if (l == 0)      RUN_STEP(EN_NORM((norm_phase<false, false, true, G1_FP8>(F, KARG(0), XB, KARG(2) + l * DM, modl, 0, DM, nullptr, nullptr, 0))));
        else if (l == 2) RUN_STEP(EN_NORM((norm_phase<true, false, false, G1_FP8>(F, XB, XB, KARG(2) + l * DM, modl, 0, DM, modp, nullptr, 0))));
        else             RUN_STEP(EN_NORM1((norm_phase<false, false, false, G1_FP8>(F, XB, nullptr, KARG(2) + l * DM, modl, 0, DM, nullptr, nullptr, 0))));
        RUN_STEP(({ pg8::Gemm g{H, (const pg8::bf16_t*)(ws + WS_WIN + (size_t)l * NPROJ * DM * (G1_FP8 ? 1 : 2)), G1_FP8 ? DM / 2 : DM}; pg8::StaticOrder S; S.init(T, NPROJ, F.G, (int)blockIdx.x);
                    pg8::EpiBf16 E{(pg8::bf16_t*)(ws + WS_PROJ), NPROJ}; EN_G1((pg8::gemm_phase<pg8::EpiBf16, pg8::StaticOrder, true, 0, G1_FP8>(ring, rowtab, g, S, E))); }));
        RUN_STEP(EN_MX(mixer_phase(F, l)));
        RUN_STEP(({ pg8::Gemm g{MIXB, (const pg8::bf16_t*)(ws + WS_WOUT) + (size_t)l * DM * DM, DM}; pg8::StaticOrder S; S.init(T, DM, F.G, (int)blockIdx.x);
                    pg8::EpiResB E{XB, (l == DEPTH - 1) ? XB2 : XB, modl + 2 * DM, NMOD, 1.0f}; EN_G2((pg8::gemm_phase<pg8::EpiResB, pg8::StaticOrder, true>(ring, rowtab, g, S, E))); }));
        const bf16* XC = (l == DEPTH - 1) ? XB2 : XB;
        if ((l & 1) == 0) {
            const int i = l >> 1;
            RUN_STEP(EN_NORM((norm_phase<false, false, false, G3_FP8>(F, XC, nullptr, KARG(3) + l * DM, modl, 3 * DM, 4 * DM, nullptr, nullptr, 0))));
            RUN_STEP(({ pg8::Gemm g{H, (const pg8::bf16_t*)(ws + WS_W13D + (size_t)i * 2 * FF * DM * (G3_FP8 ? 1 : 2)), G3_FP8 ? DM / 2 : DM}; pg8::StaticOrder S; S.init(T, 2 * FF, F.G, (int)blockIdx.x);
                        using EpiG3 = typename pg8::SelT<G4_FP8, pg8::EpiSwiglu8, pg8::EpiSwiglu>::type;
                        EpiG3 E{(decltype(EpiG3::O))(ws + WS_HID), FF};
                        EN_G3((pg8::gemm_phase<EpiG3, pg8::StaticOrder, true, 0, G3_FP8>(ring, rowtab, g, S, E))); }));
            RUN_STEP(({ pg8::Gemm g{(const pg8::bf16_t*)(ws + WS_HID), (const pg8::bf16_t*)(ws + WS_W2D + (size_t)i * DM * FF * (G4_FP8 ? 1 : 2)), G4_FP8 ? FF / 2 : FF}; pg8::StaticOrder S; S.init(T, DM, F.G, (int)blockIdx.x, 1);
                        pg8::EpiResB E{XB, XB, modl + 5 * DM, NMOD, G4_FP8 ? 1.0f / pg8::W2_8_SCALE : 1.0f}; EN_G4((pg8::gemm_phase<pg8::EpiResB, pg8::StaticOrder, true, 0, G4_FP8, !G4_FP8>(ring, rowtab, g, S, E))); }));
        } else {
            const int i = l >> 1;
            RUN_STEP(EN_NORM((norm_phase<false, true, false, true>(F, XC, nullptr, KARG(3) + l * DM, modl, 3 * DM, 4 * DM, nullptr, KARG(21) + (size_t)i * DM * NE, i))));
            RUN_STEP(EN_NORM(route_phase(F, i)));
            int ps[9]; ps[0] = 0;
            if (step + N_CHUNK + 1 >= lo && step < hi) {
#pragma unroll
                for (int e = 0; e < 8; ++e) ps[e + 1] = ps[e] + __builtin_amdgcn_readfirstlane((int)((__hip_atomic_load(F.ctl + CW_MOE + i * 64 + e, RLX_AGENT) + 255u) >> 8));
            } else {
#pragma unroll
                for (int e = 0; e < 8; ++e) ps[e + 1] = 0;
            }
            constexpr size_t HIDC_BUF = (size_t)CH0_MAX * 256 * FFE;
            const int npx = ps[8] > N_CHUNK * CH_PAN ? (ps[8] - N_CHUNK * CH_PAN > CH0_MAX - CH_PAN ? CH0_MAX - CH_PAN : ps[8] - N_CHUNK * CH_PAN) : 0, nh8 = (F.G == 256) ? ((4 * npx + 7) & ~7) : 0;
#define MOE_GEOM(c_) const int pan0 = (c_) == 0 ? 0 : CH_PAN * (c_) + npx; int npan = ps[8] - pan0; { const int cap = (c_) == 0 ? CH_PAN + npx : CH_PAN; npan = npan < 0 ? 0 : (npan > cap ? cap : npan); }
#define MOE_UP(c_, nh_) do { MOE_GEOM(c_) \
                pg8::Gemm g{H, (const pg8::bf16_t*)(ws + WS_W13E + (size_t)i * W13E_LSTRIDE), DM / 2}; \
                pg8::MoeOrder<true> S; S.so.init(npan * 256, 2 * FFE, F.G, (int)blockIdx.x, 0, (nh_), MOE_HQ); S.pan0 = pan0; S.ps1 = ps[1]; S.ps2 = ps[2]; S.ps3 = ps[3]; S.ps4 = ps[4]; S.ps5 = ps[5]; S.ps6 = ps[6]; S.ps7 = ps[7]; \
                S.estride = (size_t)2 * FFE * DM; S.rowmap = (const int*)(ws + WS_RM); \
                pg8::EpiSwiglu8 E{ws + WS_HIDC + ((c_) & 1) * HIDC_BUF, FFE}; EN_UP((pg8::gemm_phase<pg8::EpiSwiglu8, pg8::MoeOrder<true>, true, 0, true>(ring, rowtab, g, S, E))); } while (0)
#define MOE_DN(c_) do { MOE_GEOM(c_) \
                pg8::Gemm g{(const pg8::bf16_t*)(ws + WS_HIDC + ((c_) & 1) * HIDC_BUF), (const pg8::bf16_t*)(ws + WS_W2E + (size_t)i * 8 * DM * FFE), FFE / 2}; \
                pg8::MoeOrder<false> S; S.so.init(npan * 256, DM, F.G, (int)blockIdx.x, 1); S.pan0 = pan0; S.ps1 = ps[1]; S.ps2 = ps[2]; S.ps3 = ps[3]; S.ps4 = ps[4]; S.ps5 = ps[5]; S.ps6 = ps[6]; S.ps7 = ps[7]; \
                S.estride = (size_t)DM * FFE; S.rowmap = nullptr; \
                pg8::EpiBf16 E{(pg8::bf16_t*)(ws + WS_YS) + (size_t)pan0 * 256 * DM, DM}; EN_DN((pg8::gemm_phase<pg8::EpiBf16, pg8::MoeOrder<false>, true, 0, true>(ring, rowtab, g, S, E))); } while (0)
            RUN_STEP(({ MOE_UP(0, 0); }));
            for (int c = 0; c < N_CHUNK; ++c) {
                RUN_STEP(({ MOE_DN(c); if (c + 1 < N_CHUNK) { MOE_UP(c + 1, c == 0 ? nh8 : 0); } }));
            }
#undef MOE_GEOM
#undef MOE_UP
#undef MOE_DN
        }
    }
    RUN_STEP(EN_FINAL(final_phase(F, MOD + (size_t)3 * 32 * NMOD, (const bf16*)(ws + WS_XB2))));
#undef RUN_STEP
}

#ifndef N_LAUNCH_MODE
#define N_LAUNCH_MODE 1
#endif
extern "C" void kernel_launch(void* const* d_in, const int* in_sizes, int n_in, void* d_out, int out_size, void* d_ws, size_t ws_size, hipStream_t stream) {
    static int grid = 0;
    if (grid == 0) {
        if (n_in != 25 || in_sizes[0] != T * DM || out_size != T * DM || ws_size < WS_END) { fprintf(stderr, "kernel_launch: unexpected shapes (n_in %d, in0 %d, out %d, ws %zu < %zu); nothing launched\n", n_in, n_in > 0 ? in_sizes[0] : -1, out_size, ws_size, (size_t)WS_END); grid = -1; return; }
        int dev = 0, cus = 0, per_cu = 0;
        if (hipGetDevice(&dev) != hipSuccess || hipDeviceGetAttribute(&cus, hipDeviceAttributeMultiprocessorCount, dev) != hipSuccess) { grid = -1; return; }
        if (hipFuncSetAttribute((const void*)fwd_kernel, hipFuncAttributeMaxDynamicSharedMemorySize, LDS_BYTES) != hipSuccess) { fprintf(stderr, "kernel_launch: hipFuncSetAttribute failed\n"); grid = -1; return; }
        if (hipOccupancyMaxActiveBlocksPerMultiprocessor(&per_cu, (const void*)fwd_kernel, NWAVES * 64, LDS_BYTES) != hipSuccess || per_cu < 1) fprintf(stderr, "kernel_launch: occupancy query says %d\n", per_cu);
        (void)hipGetLastError();
        grid = cus;
        if (grid != 256) fprintf(stderr, "kernel_launch: %d CUs (built for 256)\n", grid);
    }
    if (grid < 0) return;
    if (hipMemsetAsync((char*)d_ws + WS_CTL, 0, CTL_ZERO_BYTES, stream) != hipSuccess) return;
    Args a{};
    for (int i = 0; i < 25; ++i) a.in[i] = (const float*)d_in[i];
    a.out = (float*)d_out; a.ws = (unsigned char*)d_ws;
#if N_LAUNCH_MODE == 1
    a.lo = 0; a.hi = N_STEPS;
    hipLaunchKernelGGL(fwd_kernel, dim3(grid), dim3(NWAVES * 64), LDS_BYTES, stream, a);
#else
    for (int s = 0; s < N_STEPS; ++s) { a.lo = s; a.hi = s + 1; hipLaunchKernelGGL(fwd_kernel, dim3(grid), dim3(NWAVES * 64), LDS_BYTES, stream, a); }
#endif
}
```

```cpp
#include <hip/hip_runtime.h>
#include <cstdio>
#include <cstdint>

namespace pg8 {
#define PG8_LAS __attribute__((address_space(3)))
typedef unsigned short bf16_t;
typedef short bf16x8 __attribute__((ext_vector_type(8)));
typedef float f32x4 __attribute__((ext_vector_type(4)));
typedef unsigned u32x4 __attribute__((ext_vector_type(4)));
constexpr int BM = 256, BK = 64, HALF = 128, HTB = HALF * BK * 2  , STAGE_BYTES = 8 * HTB, NXCD = 8, WGM = 8;

__host__ __device__ __forceinline__ int lds_byte(int r, int c) { const int st = (r >> 4) * 2 + (c >> 5), rr = r & 15, cc = c & 31, ob = rr * 64 + cc * 2; return st * 1024 + (ob ^ (((ob >> 9) & 1) << 5)); }
__host__ __device__ __forceinline__ void stage_rc(int b, int& R, int& C) { const int st = b / 1024, sb = b % 1024, swz = sb ^ (((sb >> 9) & 1) << 5); R = (st >> 1) * 16 + swz / 64; C = (st & 1) * 32 + (swz % 64) / 2; }
__host__ __device__ __forceinline__ int perm32(int rho) { const int n = rho >> 4, i = rho & 15; return 8 * (i >> 2) + 4 * n + (i & 3); }

template <bool C, class A, class B> struct SelT { typedef A type; }; template <class A, class B> struct SelT<false, A, B> { typedef B type; };
struct Unit { int pm, pn; };
struct Gemm { const bf16_t* A; const bf16_t* Bt; int K; };

struct StaticOrder {
    static constexpr bool GATHER = false;
    int nM, nN, nwg, G, c, rev, nh, hq;
    __host__ __device__ void init(int M, int N, int G_, int c_, int rev_ = 0, int nh_ = 0, int hq_ = 4) { nM = M / BM; nN = N / BM; nwg = nM * nN; G = G_; c = c_; rev = rev_; nh = nh_; hq = hq_; }
    __host__ __device__ bool next(int i, Unit& u) const {
        long L = (long)i * G + c;
        if (nh) { const int nl = G - nh, v = c >= nh ? c - nh : c + nl; if (i < hq) L = (long)i * G + v; else { if (v >= nl) return false; L = (long)hq * G + (long)(i - hq) * nl + v; } }
        if (L >= nwg) return false;
        int wgid = rev ? (nwg - 1 - (int)L) : (int)L; { const int q = nwg / NXCD, r = nwg % NXCD, xcd = wgid % NXCD, off = wgid / NXCD; wgid = (xcd < r ? xcd * (q + 1) : r * (q + 1) + (xcd - r) * q) + off; }
        const int nig = WGM * nN, gid = wgid / nig, fm = gid * WGM, gsz = (nM - fm) < WGM ? (nM - fm) : WGM;
        u.pm = fm + ((wgid % nig) % gsz); u.pn = (wgid % nig) / gsz; return true;
    }
    __device__ __forceinline__ const char* a_base(const Gemm& g, const Unit& u) const { return (const char*)g.A + (unsigned)u.pm * (unsigned)(BM * g.K * 2); }
    __device__ __forceinline__ const char* b_base(const Gemm& g, const Unit& u) const { return (const char*)g.Bt + (unsigned)u.pn * (unsigned)(BM * g.K * 2); }
    __device__ __forceinline__ int row_index(const Unit&, int) const { return 0; }
};

template <bool GATH> struct MoeOrder {
    static constexpr bool GATHER = GATH;
    StaticOrder so; int pan0; int ps1, ps2, ps3, ps4, ps5, ps6, ps7; size_t estride  ; const int* rowmap;
    __device__ __forceinline__ bool next(int i, Unit& u) const { return so.next(i, u); }
    __device__ __forceinline__ int expert_of(int p) const { return (p >= ps1) + (p >= ps2) + (p >= ps3) + (p >= ps4) + (p >= ps5) + (p >= ps6) + (p >= ps7); }
    __device__ __forceinline__ const char* a_base(const Gemm& g, const Unit& u) const { return GATH ? (const char*)g.A : (const char*)g.A + (unsigned)u.pm * (unsigned)(BM * g.K * 2); }
    __device__ __forceinline__ const char* b_base(const Gemm& g, const Unit& u) const { return (const char*)g.Bt + ((unsigned)expert_of(pan0 + u.pm) * (unsigned)estride + (unsigned)u.pn * (unsigned)(BM * g.K * 2)); }
    __device__ __forceinline__ int row_index(const Unit& u, int r) const { return rowmap[(size_t)(pan0 + u.pm) * BM + r]; }
};

typedef float f32x2_t __attribute__((ext_vector_type(2))); typedef __bf16 bf16x2_t __attribute__((ext_vector_type(2)));
__device__ __forceinline__ unsigned cvt_pk_bf16(float lo, float hi) { const f32x2_t v = {lo, hi}; const bf16x2_t b = __builtin_convertvector(v, bf16x2_t); return __builtin_bit_cast(unsigned, b); }
__device__ __forceinline__ float silu_f(float x) { return x * __builtin_amdgcn_rcpf(1.0f + __expf(-x)); }
__device__ __forceinline__ f32x2_t swiglu2(f32x2_t g, f32x2_t u) { const f32x2_t t = g * u; f32x2_t e; e.x = __builtin_amdgcn_exp2f(-g.x); e.y = __builtin_amdgcn_exp2f(-g.y); const f32x2_t d = e + 1.0f; f32x2_t r; r.x = __builtin_amdgcn_rcpf(d.x); r.y = __builtin_amdgcn_rcpf(d.y); return t * r; }
typedef int i32x4_t __attribute__((ext_vector_type(4))); typedef int i32x8_t __attribute__((ext_vector_type(8))); typedef unsigned u32x2_t __attribute__((ext_vector_type(2)));
__device__ __forceinline__ unsigned cvt_pk4_fp8(float a, float b, float c, float d) {
    a = __builtin_amdgcn_fmed3f(a, -448.f, 448.f); b = __builtin_amdgcn_fmed3f(b, -448.f, 448.f); c = __builtin_amdgcn_fmed3f(c, -448.f, 448.f); d = __builtin_amdgcn_fmed3f(d, -448.f, 448.f);
    int p = __builtin_amdgcn_cvt_pk_fp8_f32(a, b, 0, false); p = __builtin_amdgcn_cvt_pk_fp8_f32(c, d, p, true); return (unsigned)p; }
constexpr float W13_8_SCALE = 16.0f;
constexpr float W2_8_SCALE = 512.0f;

struct EpiBf16 {
    static constexpr bool PERM = true;
    bf16_t* O; int ldc;
    __device__ __forceinline__ void operator()(const f32x4 (&acc)[2][2][4][2], const Unit& u, int wr, int wc, int fr, int fq) const {
        asm volatile("" : "+v"(fr)); asm volatile("" : "+v"(fq));
        const int row0 = u.pm * BM + wr * 64 + fr, col0 = u.pn * BM + wc * 32 + 8 * fq;
#pragma unroll
        for (int ai = 0; ai < 2; ++ai)
#pragma unroll
            for (int m = 0; m < 4; ++m) { bf16_t* rowp = O + (size_t)(row0 + ai * HALF + m * 16) * ldc + col0;
#pragma unroll
                for (int bj = 0; bj < 2; ++bj) { const f32x4 v0 = acc[ai][bj][m][0], v1 = acc[ai][bj][m][1];
                    u32x4 w; w.x = cvt_pk_bf16(v0[0], v0[1]); w.y = cvt_pk_bf16(v0[2], v0[3]); w.z = cvt_pk_bf16(v1[0], v1[1]); w.w = cvt_pk_bf16(v1[2], v1[3]);
                    *(u32x4*)(rowp + bj * HALF) = w; } }
    }
};
struct EpiSwiglu {
    static constexpr bool PERM = true;
    bf16_t* O; int ldc;
    __device__ __forceinline__ void operator()(const f32x4 (&acc)[2][2][4][2], const Unit& u, int wr, int wc, int fr, int fq) const {
        asm volatile("" : "+v"(fr)); asm volatile("" : "+v"(fq));
        const int row0 = u.pm * BM + wr * 64 + fr, col0 = u.pn * HALF + wc * 32 + 8 * fq;
#pragma unroll
        for (int ai = 0; ai < 2; ++ai)
#pragma unroll
            for (int m = 0; m < 4; ++m) { bf16_t* rowp = O + (size_t)(row0 + ai * HALF + m * 16) * ldc + col0;
                const f32x4 g0 = acc[ai][0][m][0], g1 = acc[ai][0][m][1], u0 = acc[ai][1][m][0], u1 = acc[ai][1][m][1];
                float h[8];
#pragma unroll
                for (int i = 0; i < 4; i += 2) { const f32x2_t ha = swiglu2((f32x2_t){g0[i], g0[i + 1]}, (f32x2_t){u0[i], u0[i + 1]}), hb = swiglu2((f32x2_t){g1[i], g1[i + 1]}, (f32x2_t){u1[i], u1[i + 1]});
                    h[i] = ha.x; h[i + 1] = ha.y; h[4 + i] = hb.x; h[5 + i] = hb.y; }
                u32x4 w; w.x = cvt_pk_bf16(h[0], h[1]); w.y = cvt_pk_bf16(h[2], h[3]); w.z = cvt_pk_bf16(h[4], h[5]); w.w = cvt_pk_bf16(h[6], h[7]);
                *(u32x4*)rowp = w; }
    }
};
struct EpiSwiglu8 {
    static constexpr bool PERM = true;
    unsigned char* O; int ldc;
    __device__ __forceinline__ void operator()(const f32x4 (&acc)[2][2][4][2], const Unit& u, int wr, int wc, int fr, int fq) const {
        asm volatile("" : "+v"(fr)); asm volatile("" : "+v"(fq));
        const int row0 = u.pm * BM + wr * 64 + fr, col0 = u.pn * HALF + wc * 32 + 8 * fq;
#pragma unroll
        for (int ai = 0; ai < 2; ++ai)
#pragma unroll
            for (int m = 0; m < 4; ++m) { unsigned char* rowp = O + (size_t)(row0 + ai * HALF + m * 16) * ldc + col0;
                const f32x4 g0 = acc[ai][0][m][0], g1 = acc[ai][0][m][1], u0 = acc[ai][1][m][0], u1 = acc[ai][1][m][1];
                float h[8];
#pragma unroll
                for (int i = 0; i < 4; i += 2) { const f32x2_t ha = swiglu2((f32x2_t){g0[i], g0[i + 1]}, (f32x2_t){u0[i], u0[i + 1]}), hb = swiglu2((f32x2_t){g1[i], g1[i + 1]}, (f32x2_t){u1[i], u1[i + 1]});
                    h[i] = ha.x; h[i + 1] = ha.y; h[4 + i] = hb.x; h[5 + i] = hb.y; }
                u32x2_t w; w.x = cvt_pk4_fp8(h[0], h[1], h[2], h[3]); w.y = cvt_pk4_fp8(h[4], h[5], h[6], h[7]);
                *(u32x2_t*)rowp = w; }
    }
};
struct EpiRes {
    static constexpr bool PERM = false;
    const float* xin; float* xout; const float* gate; int gstride;
    __device__ __forceinline__ void operator()(const f32x4 (&acc)[2][2][4][2], const Unit& u, int wr, int wc, int fr, int fq) const {
        asm volatile("" : "+v"(fr)); asm volatile("" : "+v"(fq));
        const int row0 = u.pm * BM + wr * 64 + fr, col0 = u.pn * BM + wc * 32 + 4 * fq;
        const float* gp = gate + (size_t)(u.pm >> 3) * gstride + col0;
        f32x4 gv[2][2];
#pragma unroll
        for (int bj = 0; bj < 2; ++bj)
#pragma unroll
            for (int n = 0; n < 2; ++n) gv[bj][n] = *(const f32x4*)(gp + bj * HALF + n * 16);
#pragma unroll
        for (int ai = 0; ai < 2; ++ai) {
            f32x4 xi[4][2][2];
#pragma unroll
            for (int m = 0; m < 4; ++m) { const size_t off = (size_t)(row0 + ai * HALF + m * 16) * 1024 + col0;
#pragma unroll
                for (int bj = 0; bj < 2; ++bj)
#pragma unroll
                    for (int n = 0; n < 2; ++n) xi[m][bj][n] = *(const f32x4*)(xin + off + bj * HALF + n * 16); }
            asm volatile("" ::: "memory");
#pragma unroll
            for (int m = 0; m < 4; ++m) { const size_t off = (size_t)(row0 + ai * HALF + m * 16) * 1024 + col0;
#pragma unroll
                for (int bj = 0; bj < 2; ++bj)
#pragma unroll
                    for (int n = 0; n < 2; ++n) *(f32x4*)(xout + off + bj * HALF + n * 16) = xi[m][bj][n] + gv[bj][n] * acc[ai][bj][m][n]; }
            asm volatile("" ::: "memory");
        }
    }
};

struct EpiResB {
    static constexpr bool PERM = true;
    const bf16_t* xin; bf16_t* xout; const float* gate; int gstride; float gs;
    __device__ __forceinline__ void operator()(const f32x4 (&acc)[2][2][4][2], const Unit& u, int wr, int wc, int fr, int fq) const {
        asm volatile("" : "+v"(fr)); asm volatile("" : "+v"(fq));
        const int row0 = u.pm * BM + wr * 64 + fr, col0 = u.pn * BM + wc * 32 + 8 * fq;
        const float* gp = gate + (size_t)(u.pm >> 3) * gstride + col0;
        f32x4 gv[2][2];
#pragma unroll
        for (int bj = 0; bj < 2; ++bj)
#pragma unroll
            for (int n = 0; n < 2; ++n) gv[bj][n] = *(const f32x4*)(gp + bj * HALF + 4 * n) * gs;
#pragma unroll
        for (int ai = 0; ai < 2; ++ai) {
            u32x4 xi[4][2];
#pragma unroll
            for (int m = 0; m < 4; ++m)
#pragma unroll
                for (int bj = 0; bj < 2; ++bj) xi[m][bj] = *(const u32x4*)(xin + (size_t)(row0 + ai * HALF + m * 16) * 1024 + col0 + bj * HALF);
            asm volatile("" ::: "memory");
#pragma unroll
            for (int m = 0; m < 4; ++m)
#pragma unroll
                for (int bj = 0; bj < 2; ++bj) { const u32x4 x = xi[m][bj]; const f32x4 a0 = acc[ai][bj][m][0], a1 = acc[ai][bj][m][1], g0 = gv[bj][0], g1 = gv[bj][1];
                    u32x4 w;
                    w.x = cvt_pk_bf16(__builtin_bit_cast(float, x.x << 16) + g0[0] * a0[0], __builtin_bit_cast(float, x.x & 0xffff0000u) + g0[1] * a0[1]);
                    w.y = cvt_pk_bf16(__builtin_bit_cast(float, x.y << 16) + g0[2] * a0[2], __builtin_bit_cast(float, x.y & 0xffff0000u) + g0[3] * a0[3]);
                    w.z = cvt_pk_bf16(__builtin_bit_cast(float, x.z << 16) + g1[0] * a1[0], __builtin_bit_cast(float, x.z & 0xffff0000u) + g1[1] * a1[1]);
                    w.w = cvt_pk_bf16(__builtin_bit_cast(float, x.w << 16) + g1[2] * a1[2], __builtin_bit_cast(float, x.w & 0xffff0000u) + g1[3] * a1[3]);
                    *(u32x4*)(xout + (size_t)(row0 + ai * HALF + m * 16) * 1024 + col0 + bj * HALF) = w; }
            asm volatile("" ::: "memory");
        }
    }
};

template <class Epi, class Sched, bool ALIGN_EPI, int VAR = 0, bool FP8 = false, bool ZC = true, int KC = 0>
__device__ __forceinline__ void gemm_phase(PG8_LAS unsigned char* lds, PG8_LAS int* rowtab, const Gemm g, const Sched& S, const Epi& E) {
    int tid_ = threadIdx.x; asm volatile("" : "+v"(tid_));
    const int tid = tid_, wid = __builtin_amdgcn_readfirstlane(tid >> 6), lane = tid & 63, wr = wid >> 2, wc = wid & 3, fr = lane & 15, fq = lane >> 4;
    const int K = KC ? KC : g.K, nt = K / BK;
    unsigned voffA[2], voffB[2];
#pragma unroll
    for (int i = 0; i < 2; ++i) { int R, C; stage_rc(tid * 16 + i * 8192, R, C); const int Rb = Epi::PERM ? ((R & ~31) + perm32(R & 31)) : R;
        voffA[i] = (unsigned)(R * K + C) * 2u; voffB[i] = (unsigned)(Rb * K + C) * 2u; }
    const size_t kstep = (size_t)(BK * 2);
    const size_t hstep = (size_t)HALF * K * 2;
    const unsigned ldsw = (unsigned)wid * 1024u;
    const int aoff = lds_byte(wr * 64 + fr, fq * 8), boff = lds_byte(wc * 32 + fr, fq * 8);
#define PG8_SA(b, h) (((b) * 2 + (h)) * HTB)
#define PG8_SB(b, h) ((4 + (b) * 2 + (h)) * HTB)
#define PG8_STAGE(bufoff, gbase, voff) do { if constexpr (VAR != 2) _Pragma("unroll") for (int _i = 0; _i < 2; ++_i) \
        __builtin_amdgcn_global_load_lds((const unsigned*)((const char*)(gbase) + (voff)[_i]), (PG8_LAS unsigned*)(lds + (bufoff) + ldsw + _i * 8192), 16, 0, 0); } while (0)
#define PG8_STA(bufoff, h, ptr, GO) do { if constexpr (Sched::GATHER) { PG8_STAGE(bufoff, ptr, GO[h]); } else { PG8_STAGE(bufoff, (ptr) + (h) * hstep, voffA); } } while (0)
#define PG8_LDA(dst, b, h) do { _Pragma("unroll") for (int m = 0; m < 4; ++m) _Pragma("unroll") for (int k = 0; k < 2; ++k) dst[m][k] = *(const PG8_LAS bf16x8*)(lds + PG8_SA(b, h) + aoff + m * 2048 + k * 1024); } while (0)
#define PG8_LDB(dst, b, h) do { _Pragma("unroll") for (int n = 0; n < 2; ++n) _Pragma("unroll") for (int k = 0; k < 2; ++k) dst[n][k] = *(const PG8_LAS bf16x8*)(lds + PG8_SB(b, h) + boff + n * 2048 + k * 1024); } while (0)
#define PG8_MMA(ai, bj, At, Bt) do { __builtin_amdgcn_s_setprio(1); if constexpr (VAR != 1) { if constexpr (FP8) { _Pragma("unroll") for (int m = 0; m < 4; ++m) _Pragma("unroll") for (int n = 0; n < 2; ++n) \
        asm volatile("v_mfma_f32_16x16x128_f8f6f4 %0, %1, %2, %0" : "+v"(acc[ai][bj][m][n]) : "v"(__builtin_shufflevector(__builtin_bit_cast(i32x4_t, Bt[n][0]), __builtin_bit_cast(i32x4_t, Bt[n][1]), 0, 1, 2, 3, 4, 5, 6, 7)), \
            "v"(__builtin_shufflevector(__builtin_bit_cast(i32x4_t, At[m][0]), __builtin_bit_cast(i32x4_t, At[m][1]), 0, 1, 2, 3, 4, 5, 6, 7))); } \
        else { _Pragma("unroll") for (int m = 0; m < 4; ++m) _Pragma("unroll") for (int n = 0; n < 2; ++n) _Pragma("unroll") for (int k = 0; k < 2; ++k) \
        acc[ai][bj][m][n] = __builtin_amdgcn_mfma_f32_16x16x32_bf16(Bt[n][k], At[m][k], acc[ai][bj][m][n], 0, 0, 0); } } __builtin_amdgcn_s_setprio(0); } while (0)
#define PG8_MMA0(ai, bj, At, Bt) do { if constexpr (VAR != 1 && ZC) { if (t == 0) { __builtin_amdgcn_s_setprio(1); \
        if constexpr (FP8) { _Pragma("unroll") for (int m = 0; m < 4; ++m) _Pragma("unroll") for (int n = 0; n < 2; ++n) \
        asm volatile("v_mfma_f32_16x16x128_f8f6f4 %0, %1, %2, 0" : "+v"(acc[ai][bj][m][n]) : "v"(__builtin_shufflevector(__builtin_bit_cast(i32x4_t, Bt[n][0]), __builtin_bit_cast(i32x4_t, Bt[n][1]), 0, 1, 2, 3, 4, 5, 6, 7)), \
            "v"(__builtin_shufflevector(__builtin_bit_cast(i32x4_t, At[m][0]), __builtin_bit_cast(i32x4_t, At[m][1]), 0, 1, 2, 3, 4, 5, 6, 7))); } \
        else { _Pragma("unroll") for (int m = 0; m < 4; ++m) _Pragma("unroll") for (int n = 0; n < 2; ++n) asm volatile("v_mfma_f32_16x16x32_bf16 %0, %1, %2, 0" : "+v"(acc[ai][bj][m][n]) : "v"(Bt[n][0]), "v"(At[m][0])); \
               _Pragma("unroll") for (int m = 0; m < 4; ++m) _Pragma("unroll") for (int n = 0; n < 2; ++n) asm volatile("v_mfma_f32_16x16x32_bf16 %0, %1, %2, %0" : "+v"(acc[ai][bj][m][n]) : "v"(Bt[n][1]), "v"(At[m][1])); } \
        __builtin_amdgcn_s_setprio(0); } else { PG8_MMA(ai, bj, At, Bt); } } else { PG8_MMA(ai, bj, At, Bt); } } while (0)
#define PG8_WAIT_V(n) asm volatile("s_waitcnt vmcnt(" #n ")" ::: "memory")
#define PG8_WAIT_L(n) asm volatile("s_waitcnt lgkmcnt(" #n ")" ::: "memory")
#define PG8_BAR __builtin_amdgcn_s_barrier()
#define PG8_SCHED __builtin_amdgcn_sched_barrier(0)
    Unit cur, nxt; int ui = 0;
    if (!S.next(0, cur)) return;
    unsigned gc[2][2], gs[2][2];
    if constexpr (Sched::GATHER) {
        Unit tu;
        for (int i = 0; i < 16 && S.next(i, tu); ++i) if (tid < 256) rowtab[i * 256 + tid] = S.row_index(tu, tid);
        asm volatile("s_waitcnt vmcnt(0) lgkmcnt(0)" ::: "memory"); PG8_BAR; asm volatile("" ::: "memory");
#pragma unroll
        for (int h = 0; h < 2; ++h)
#pragma unroll
            for (int i = 0; i < 2; ++i) { int R, C; stage_rc(tid * 16 + i * 8192, R, C); gc[h][i] = (unsigned)rowtab[h * HALF + R] * (unsigned)(K * 2) + (unsigned)C * 2u; gs[h][i] = gc[h][i]; }
    } else {
#pragma unroll
        for (int h = 0; h < 2; ++h)
#pragma unroll
            for (int i = 0; i < 2; ++i) { gc[h][i] = 0u; gs[h][i] = 0u; }
    }
    f32x4 acc[2][2][4][2];
#pragma unroll
    for (int a = 0; a < 2; ++a)
#pragma unroll
        for (int b = 0; b < 2; ++b)
#pragma unroll
            for (int m = 0; m < 4; ++m)
#pragma unroll
                for (int n = 0; n < 2; ++n) acc[a][b][m][n] = (f32x4){0.f, 0.f, 0.f, 0.f};
    bf16x8 At[4][2], B0[2][2], B1[2][2];
    const char* cA = S.a_base(g, cur); const char* cB = S.b_base(g, cur);
    PG8_STAGE(PG8_SB(0, 0), cB, voffB); PG8_STAGE(PG8_SB(0, 1), cB + hstep, voffB); PG8_STA(PG8_SA(0, 0), 0, cA, gc); PG8_STA(PG8_SA(0, 1), 1, cA, gc);
    if (wr == 1) PG8_BAR;
    PG8_WAIT_V(2); PG8_BAR;
    PG8_STAGE(PG8_SB(1, 0), cB + kstep, voffB); PG8_STA(PG8_SA(1, 0), 0, cA + kstep, gc); PG8_STAGE(PG8_SB(1, 1), cB + hstep + kstep, voffB);
    PG8_WAIT_V(6); PG8_BAR;
    for (;;) {
        const bool has_next = S.next(ui + 1, nxt);
        const char* nA = has_next ? S.a_base(g, nxt) : cA; const char* nB = has_next ? S.b_base(g, nxt) : cB;
        for (int t = 0; t < nt; t += 2) {
            const bool last = (t == nt - 2);
            const char* a1 = cA + (size_t)(t + 1) * kstep;
            const char* a2 = last ? nA : cA + (size_t)(t + 2) * kstep; const char* b2 = last ? nB : cB + (size_t)(t + 2) * kstep;
            const char* a3 = a2 + kstep; const char* b3 = b2 + kstep;
            if constexpr (Sched::GATHER) {
                if (last && has_next) {
#pragma unroll
                    for (int h = 0; h < 2; ++h)
#pragma unroll
                        for (int i = 0; i < 2; ++i) { int t2 = tid; asm volatile("" : "+v"(t2)); int R, C; stage_rc(t2 * 16 + i * 8192, R, C); gs[h][i] = (unsigned)rowtab[(ui + 1) * 256 + h * HALF + R] * (unsigned)(K * 2) + (unsigned)C * 2u; }
                }
            }
            PG8_LDB(B0, 0, 0); PG8_LDB(B1, 0, 1); PG8_SCHED; PG8_LDA(At, 0, 0); PG8_STA(PG8_SA(1, 1), 1, a1, gc);
            PG8_WAIT_V(8); PG8_WAIT_L(0); PG8_BAR; PG8_MMA0(0, 0, At, B0); PG8_MMA0(0, 1, At, B1); PG8_BAR; PG8_SCHED;
            PG8_LDA(At, 0, 1); PG8_STAGE(PG8_SB(0, 0), b2, voffB); PG8_STAGE(PG8_SB(0, 1), b2 + hstep, voffB); PG8_STA(PG8_SA(0, 0), 0, a2, gs);
            PG8_WAIT_V(8); PG8_WAIT_L(0); PG8_BAR; PG8_MMA0(1, 0, At, B0); PG8_MMA0(1, 1, At, B1); PG8_BAR; PG8_SCHED;
            PG8_LDB(B0, 1, 0); PG8_LDB(B1, 1, 1); PG8_SCHED; PG8_LDA(At, 1, 0); PG8_STA(PG8_SA(0, 1), 1, a2, gs);
            PG8_WAIT_V(8); PG8_WAIT_L(0); PG8_BAR; PG8_MMA(0, 0, At, B0); PG8_MMA(0, 1, At, B1); PG8_BAR; PG8_SCHED;
            PG8_LDA(At, 1, 1); PG8_STAGE(PG8_SB(1, 0), b3, voffB); PG8_STAGE(PG8_SB(1, 1), b3 + hstep, voffB); PG8_STA(PG8_SA(1, 0), 0, a3, gs);
            PG8_WAIT_V(8); PG8_WAIT_L(0); PG8_BAR; PG8_MMA(1, 0, At, B0); PG8_MMA(1, 1, At, B1); PG8_BAR; PG8_SCHED;
        }
        if constexpr (ALIGN_EPI) { if (wr == 0) PG8_BAR; }
        if constexpr (FP8) asm volatile("s_nop 15\n\ts_nop 15" ::: "memory");
        if constexpr (VAR != 3) E(acc, cur, wr, wc, fr, fq);
        if (!has_next) break;
        if constexpr (VAR == 1 || !ZC) {
#pragma unroll
        for (int a = 0; a < 2; ++a)
#pragma unroll
            for (int b = 0; b < 2; ++b)
#pragma unroll
                for (int m = 0; m < 4; ++m)
#pragma unroll
                    for (int n = 0; n < 2; ++n) acc[a][b][m][n] = (f32x4){0.f, 0.f, 0.f, 0.f};
        }
        cur = nxt; cA = nA; cB = nB; ++ui;
        if constexpr (Sched::GATHER) {
#pragma unroll
            for (int h = 0; h < 2; ++h)
#pragma unroll
                for (int i = 0; i < 2; ++i) gc[h][i] = gs[h][i];
        }
        if constexpr (ALIGN_EPI) { if (wr == 1) PG8_BAR; }
    }
    PG8_WAIT_V(0);
    if constexpr (!ALIGN_EPI) { if (wr == 0) PG8_BAR; }
    PG8_BAR;
#undef PG8_SA
#undef PG8_SB
#undef PG8_STAGE
#undef PG8_STA
#undef PG8_LDA
#undef PG8_LDB
#undef PG8_MMA
#undef PG8_MMA0
#undef PG8_WAIT_V
#undef PG8_WAIT_L
#undef PG8_BAR
#undef PG8_SCHED
}
}

#define GAS __attribute__((address_space(1)))
#define LAS __attribute__((address_space(3)))
typedef unsigned short bf16;
typedef unsigned v4u __attribute__((ext_vector_type(4)));
typedef float f32x4 __attribute__((ext_vector_type(4)));
typedef short bf16x8 __attribute__((ext_vector_type(8)));
typedef GAS unsigned gu32;
typedef GAS unsigned long long gu64;
#define RLX_AGENT __ATOMIC_RELAXED, __HIP_MEMORY_SCOPE_AGENT
#define LDS_WAIT() asm volatile("s_waitcnt lgkmcnt(0)" ::: "memory")
#define VM_WAIT() asm volatile("s_waitcnt vmcnt(0)" ::: "memory")
__device__ __forceinline__ unsigned long long rt() { return __builtin_amdgcn_s_memrealtime(); }
__device__ __forceinline__ unsigned f2bf(float f) { unsigned u = __builtin_bit_cast(unsigned, f); return (u + 0x7fffu + ((u >> 16) & 1u)) >> 16; }
__device__ __forceinline__ unsigned pk2(float lo, float hi) { return f2bf(lo) | (f2bf(hi) << 16); }

#define XB_TMO      128
#define XB_XCNT(j)  (256  + 64 * (j))
#define XB_XSUB(j)  (1280 + 64 * (j))
#define XB_XGEN(j)  (2304 + 64 * (j))
#define XB_TOP      3328
#define XB_TOPGEN   3392
#define XCD_BAR_WORDS 3456
#define XB_SPIN_CAP (1u << 18)

__device__ __forceinline__ unsigned xb_ld(unsigned* p)              { return __hip_atomic_load(p, __ATOMIC_RELAXED, __HIP_MEMORY_SCOPE_AGENT); }
__device__ __forceinline__ unsigned xb_add(unsigned* p, unsigned v) { return __hip_atomic_fetch_add(p, v, __ATOMIC_RELAXED, __HIP_MEMORY_SCOPE_AGENT); }
__device__ __forceinline__ unsigned xb_xcc_id() { return (unsigned)__builtin_amdgcn_s_getreg((3 << 11) | 20) & 0xFu; }
#define XB_SPIN(cond, bar) do { unsigned _sp = 0; while (cond) { __builtin_amdgcn_s_sleep(1); \
    if ((++_sp & 255u) == 0u) { if (xb_ld(&(bar)[XB_TMO])) break; if (_sp > XB_SPIN_CAP) { atomicAdd(&(bar)[XB_TMO], 1u); break; } } } } while (0)

struct XcdBarrier {
    unsigned* bar; unsigned x;
    volatile LAS unsigned* st;
};

__device__ __forceinline__ XcdBarrier xcd_barrier_post(unsigned* bar, volatile LAS unsigned* st) {
    XcdBarrier b; b.bar = bar; b.x = xb_xcc_id(); b.st = st;
    if (threadIdx.x == 0) (void)xb_add(&bar[XB_XCNT(b.x)], 1u);
    return b;
}
__device__ __forceinline__ void xcd_barrier_complete(unsigned* bar, unsigned x, unsigned& nloc, unsigned& nx) {
    const unsigned G = gridDim.x * gridDim.y * gridDim.z;
    unsigned sum, cnt, mine, sp = 0u;
    for (;;) {
        sum = 0u; cnt = 0u; mine = 0u;
#pragma unroll
        for (unsigned j = 0; j < 16; ++j) { const unsigned c = xb_ld(&bar[XB_XCNT(j)]); sum += c; cnt += (c > 0u) ? 1u : 0u; mine = (j == x) ? c : mine; }
        if (sum == G) break;
        __builtin_amdgcn_s_sleep(1);
        if ((++sp & 255u) == 0u) { if (xb_ld(&bar[XB_TMO])) break; if (sp > XB_SPIN_CAP) { atomicAdd(&bar[XB_TMO], 1u); break; } }
    }
    nloc = mine > 0u ? mine : 1u; nx = cnt > 0u ? cnt : 1u;
}

__device__ __forceinline__ void xcd_barrier(const XcdBarrier& b) {
    asm volatile("s_waitcnt vmcnt(0)" ::: "memory");
    __syncthreads();
    if (threadIdx.x == 0) {
        unsigned* bar = b.bar;
        __builtin_amdgcn_s_waitcnt(0);
        unsigned nloc = b.st[0], nx = b.st[1];
        if (nloc == 0u) { xcd_barrier_complete(bar, b.x, nloc, nx); b.st[0] = nloc; b.st[1] = nx; }
        const unsigned old = xb_add(&bar[XB_XSUB(b.x)], 1u);
        const unsigned gen = old / nloc;
        if (old + 1u == (gen + 1u) * nloc) {
            __builtin_amdgcn_fence(__ATOMIC_RELEASE, "agent");
            asm volatile("s_waitcnt vmcnt(0)" ::: "memory");
            const unsigned og = xb_add(&bar[XB_TOP], 1u);
            const unsigned tg = og / nx;
            if (og + 1u == (tg + 1u) * nx) xb_add(&bar[XB_TOPGEN], 1u);
            else XB_SPIN(xb_ld(&bar[XB_TOPGEN]) == tg, bar);
            __builtin_amdgcn_fence(__ATOMIC_ACQUIRE, "agent");
            xb_add(&bar[XB_XGEN(b.x)], 1u);
            asm volatile("s_waitcnt vmcnt(0)" ::: "memory");
        } else {
            XB_SPIN(xb_ld(&bar[XB_XGEN(b.x)]) == gen, bar);
            __builtin_amdgcn_fence(__ATOMIC_ACQUIRE, "agent");
            asm volatile("s_waitcnt vmcnt(0)" ::: "memory");
        }
    }
    __syncthreads();
}


constexpr int NWAVES = 8;
constexpr int NB = 32, SEQ = 2048, T = NB * SEQ, DM = 1024, DEPTH = 4;
constexpr int NPROJ = 3328;
constexpr int NIN = 3088;
constexpr int FF = 2816, FFE = 3584, NE = 8;
constexpr int NMOD = 6 * DM;
constexpr float EPS = 1e-6f;
constexpr bool G1_FP8 = false, G3_FP8 = true, G4_FP8 = true;
constexpr int C_CB = 0, C_CC = 256, C_CX = 512, C_SU = 768, C_SV = 1024;
constexpr int C_GLA = 1280, GLA_W = 224, C_HGR = 2176, HGR_W = 256;
static_assert(C_HGR == C_GLA + 4 * GLA_W && C_HGR + 4 * HGR_W == 3200, "projection column map");
constexpr int MOE_ROWS = 2 * T + NE * 256;
constexpr int CH_PAN = 128, CH0_MAX = 136;
constexpr int N_CHUNK = 4;
constexpr int MOE_HQ = CH_PAN * (2 * FFE / 256) / 256 - 3;
static_assert((N_CHUNK - 1) * CH_PAN + CH0_MAX >= MOE_ROWS / 256, "MoE chunks cover every panel");

constexpr size_t MiB = 1u << 20;
constexpr size_t WS_CTL = 0, CTL_ZERO_BYTES = 64 * 1024;
constexpr size_t WS_MOD = 1 * MiB;
constexpr size_t WS_LB = 4 * MiB;
constexpr size_t WS_RE = 5 * MiB;
constexpr size_t WS_RW = 5 * MiB + 512 * 1024;
constexpr size_t WS_RP = 6 * MiB;
constexpr size_t WS_RM = 7 * MiB;
constexpr size_t WS_WIN = 8 * MiB;
constexpr size_t WS_WOUT = 34 * MiB;
constexpr size_t WS_W13D = 42 * MiB;
constexpr size_t WS_W2D = 64 * MiB;
constexpr size_t WS_W13E = 75 * MiB;
constexpr size_t WS_W2E = 299 * MiB;
constexpr size_t WS_H = 411 * MiB;
constexpr size_t WS_MIX = 539 * MiB;
constexpr size_t WS_PROJ = 667 * MiB;
constexpr size_t WS_HID = WS_PROJ;
constexpr size_t WS_YS = WS_MIX;
constexpr size_t WS_HIDC = 799 * MiB;
constexpr size_t WS_XB2 = 42 * MiB;
constexpr size_t WS_END = 1083 * MiB;
constexpr size_t W13E_LSTRIDE = (size_t)8 * 2 * FFE * DM * 2;
static_assert(WS_WIN + (size_t)4 * NPROJ * DM * 2 <= WS_WOUT && WS_W13D + (size_t)2 * 2 * FF * DM * 2 <= WS_W2D && WS_W2D + (size_t)2 * DM * FF * 2 <= WS_W13E, "ws map 1");
static_assert(WS_W13E + (size_t)16 * 2 * FFE * DM * 2 <= WS_W2E && WS_W2E + (size_t)16 * DM * FFE * 2 <= WS_H && WS_H + (size_t)T * DM * 2 <= WS_MIX && WS_MIX + (size_t)T * DM * 2 <= WS_PROJ, "ws map 2");
static_assert(WS_PROJ + (size_t)T * NPROJ * 2 <= WS_END && WS_HID + (size_t)T * FF * 2 <= WS_END && WS_YS + (size_t)MOE_ROWS * DM * 2 <= WS_HIDC && WS_HIDC + (size_t)2 * CH0_MAX * 256 * FFE <= WS_END, "ws map 3");
static_assert(WS_RM + (size_t)MOE_ROWS * 4 <= WS_WIN, "ws map 4");
static_assert(WS_XB2 >= WS_W13D && WS_XB2 + (size_t)T * DM * 2 <= WS_W13E + (size_t)8 * 2 * FFE * DM * 2, "the late residual copy only covers weights of finished layers");
constexpr int CW_TMO = 0, CW_CODE = 1;
constexpr int CW_BAR = 4096;
constexpr int CW_MOE = 8192;

constexpr int RING_OFF = 0, RING_BYTES = 131072;
constexpr int LDSCTL_OFF = RING_BYTES;
constexpr int ROWTAB_OFF = RING_BYTES + 1024;
constexpr int ROWTAB_UNITS = 16;
constexpr int LDS_BYTES = 151552;
static_assert(ROWTAB_OFF + ROWTAB_UNITS * 1024 <= LDS_BYTES, "LDS map");


typedef float f32x2 __attribute__((ext_vector_type(2)));
typedef unsigned u32x2 __attribute__((ext_vector_type(2)));
typedef int i32x2 __attribute__((ext_vector_type(2)));
#define KARG(i) (*(const float* const volatile __attribute__((address_space(4)))*)((const __attribute__((address_space(4))) char*)__builtin_amdgcn_kernarg_segment_ptr() + 8 * (i)))
struct Frame {
    LAS unsigned char* lds;
    volatile LAS unsigned* MISC;
    gu32* ctl;
    unsigned char* ws;
    float* out;
    int tid, lane, wave, vcu, G;
};
#define LDS_BARRIER() do { asm volatile("s_waitcnt lgkmcnt(0)" ::: "memory"); __builtin_amdgcn_s_barrier(); asm volatile("" ::: "memory"); } while (0)
__device__ __forceinline__ float wave_sum(float v) {
#pragma unroll
    for (int o = 1; o < 64; o <<= 1) v += __shfl_xor(v, o);
    return v;
}
__device__ __forceinline__ float bflo(unsigned u) { return __builtin_bit_cast(float, u << 16); }
__device__ __forceinline__ float bfhi(unsigned u) { return __builtin_bit_cast(float, u & 0xffff0000u); }
__device__ __forceinline__ f32x4 ld_bf4(const bf16* p) { const u32x2 u = *(const u32x2*)p; return (f32x4){bflo(u.x), bfhi(u.x), bflo(u.y), bfhi(u.y)}; }
__device__ __forceinline__ void st_bf4(bf16* p, f32x4 v) { u32x2 u; u.x = pg8::cvt_pk_bf16(v[0], v[1]); u.y = pg8::cvt_pk_bf16(v[2], v[3]); *(u32x2*)p = u; }
__device__ __forceinline__ f32x4 ld_bf4_reg(f32x4 v) { const unsigned a = pg8::cvt_pk_bf16(v[0], v[1]), c = pg8::cvt_pk_bf16(v[2], v[3]); return (f32x4){bflo(a), bfhi(a), bflo(c), bfhi(c)}; }
__device__ __forceinline__ float sigmoid_f(float x) { return __builtin_amdgcn_rcpf(1.0f + __expf(-x)); }
__device__ __forceinline__ float silu_f(float x) { return x * sigmoid_f(x); }
__device__ __forceinline__ float logsigmoid_f(float z) { return fminf(z, 0.f) - __logf(1.0f + __expf(-fabsf(z))); }

__device__ __forceinline__ void p0_item(const float* W, int ldw, int k0, int ns0, bf16* WT, int ldt, int drow0, int nvalid, LAS float* scr, int lane, float scale = 1.0f) {
    {   const int seg = lane & 7, r8 = lane >> 3;
        f32x4 v[8];
#pragma unroll
        for (int i = 0; i < 8; ++i) v[i] = *(const f32x4*)(W + (size_t)(k0 + 8 * i + r8) * ldw + ns0 + 4 * seg);
        asm volatile("" ::: "memory");
#pragma unroll
        for (int i = 0; i < 8; ++i) { LAS float* sp = scr + (8 * i + r8) * 33 + 4 * seg; sp[0] = v[i][0] * scale; sp[1] = v[i][1] * scale; sp[2] = v[i][2] * scale; sp[3] = v[i][3] * scale; }
    }
    LDS_WAIT(); asm volatile("" ::: "memory");
    const int c = lane & 7;
#pragma unroll
    for (int j = 0; j < 4; ++j) { const int n = (lane >> 3) + 8 * j; const LAS float* s = scr + (8 * c) * 33 + n;
        v4u o; o.x = pk2(s[0 * 33], s[1 * 33]); o.y = pk2(s[2 * 33], s[3 * 33]); o.z = pk2(s[4 * 33], s[5 * 33]); o.w = pk2(s[6 * 33], s[7 * 33]);
        if (n >= nvalid) o = (v4u){0u, 0u, 0u, 0u};
        *(GAS v4u*)(WT + (size_t)(drow0 + n) * ldt + k0 + 8 * c) = o; }
    LDS_WAIT(); asm volatile("" ::: "memory");
}
__device__ __forceinline__ void p0_item8(const float* W, int ldw, int k0, int ns0, unsigned char* WT8, int ldt, int drow0, LAS float* scr, int lane, float scale) {
    {   const int seg = lane & 7, r8 = lane >> 3;
        f32x4 v[8];
#pragma unroll
        for (int i = 0; i < 8; ++i) v[i] = *(const f32x4*)(W + (size_t)(k0 + 8 * i + r8) * ldw + ns0 + 4 * seg);
        asm volatile("" ::: "memory");
#pragma unroll
        for (int i = 0; i < 8; ++i) { LAS float* sp = scr + (8 * i + r8) * 33 + 4 * seg; sp[0] = v[i][0] * scale; sp[1] = v[i][1] * scale; sp[2] = v[i][2] * scale; sp[3] = v[i][3] * scale; }
    }
    LDS_WAIT(); asm volatile("" ::: "memory");
    const int c = lane & 7;
#pragma unroll
    for (int j = 0; j < 4; ++j) { const int n = (lane >> 3) + 8 * j; const LAS float* s = scr + (8 * c) * 33 + n;
        pg8::u32x2_t o; o.x = pg8::cvt_pk4_fp8(s[0 * 33], s[1 * 33], s[2 * 33], s[3 * 33]); o.y = pg8::cvt_pk4_fp8(s[4 * 33], s[5 * 33], s[6 * 33], s[7 * 33]);
        *(GAS pg8::u32x2_t*)(WT8 + (size_t)(drow0 + n) * ldt + k0 + 8 * c) = o; }
    LDS_WAIT(); asm volatile("" ::: "memory");
}
__device__ __forceinline__ int swi_row(int ns0) { return 256 * (ns0 >> 7) + (ns0 & 127); }

__device__ __forceinline__ void p0_prologue(Frame& F) {
    unsigned char* ws = F.ws;
    __syncthreads();
    for (int u = F.vcu; u < 48; u += F.G) {
        LAS float* condT = (LAS float*)(F.lds + RING_OFF);
        const float* cin = KARG(1);
        for (int idx = F.tid; idx < 32768; idx += NWAVES * 64) { const int k = idx >> 5, b = idx & 31; const float cv = cin[b * 1024 + k]; condT[idx] = cv * sigmoid_f(cv); }
        __syncthreads();
        const int l = u / 12, n = (u % 12) * 512 + F.tid;
        float acc[32];
#pragma unroll
        for (int b = 0; b < 32; ++b) acc[b] = 0.f;
        const float* wp = KARG(5) + (size_t)l * 1024 * NMOD + n;
#pragma unroll 4
        for (int k = 0; k < 1024; ++k) { const float w = wp[(size_t)k * NMOD];
#pragma unroll
            for (int b4 = 0; b4 < 8; ++b4) { const f32x4 cv = *(const LAS f32x4*)(condT + k * 32 + 4 * b4);
                acc[4 * b4] += cv[0] * w; acc[4 * b4 + 1] += cv[1] * w; acc[4 * b4 + 2] += cv[2] * w; acc[4 * b4 + 3] += cv[3] * w; } }
        float* mod = (float*)(ws + WS_MOD); const float bb = KARG(6)[l * NMOD + n];
#pragma unroll
        for (int b = 0; b < 32; ++b) mod[(size_t)(l * 32 + b) * NMOD + n] = acc[b] + bb;
        __syncthreads();
    }
    if (F.vcu == F.G - 1 && F.tid < 256) {
        const int c = F.tid; const float* h = KARG(16); float* lb = (float*)(ws + WS_LB);
        const float h0 = h[c], h1 = h[256 + c], h2 = h[512 + c], h3 = h[768 + c], mx = fmaxf(fmaxf(h0, h1), fmaxf(h2, h3));
        const float e0 = __expf(h0 - mx), e1 = __expf(h1 - mx), e2 = __expf(h2 - mx), e3 = __expf(h3 - mx), inv = 1.0f / (e0 + e1 + e2 + e3);
        lb[c] = 0.f; lb[256 + c] = e1 * inv; lb[512 + c] = (e1 + e2) * inv; lb[768 + c] = (e1 + e2 + e3) * inv;
    }
    {   bf16* WIN = (bf16*)(ws + WS_WIN); unsigned char* WIN8 = ws + WS_WIN; const int per = 128 * 1024 / (G1_FP8 ? 16 : 8);
        for (int idx = F.vcu * NWAVES * 64 + F.tid; idx < 4 * per; idx += F.G * NWAVES * 64) { const int l = idx / per, r = idx % per;
            if constexpr (G1_FP8) *(GAS v4u*)(WIN8 + (size_t)l * NPROJ * 1024 + (size_t)3200 * 1024 + (size_t)r * 16) = (v4u){0u, 0u, 0u, 0u};
            else *(GAS v4u*)(WIN + (size_t)l * NPROJ * 1024 + (size_t)3200 * 1024 + (size_t)r * 8) = (v4u){0u, 0u, 0u, 0u}; }
        const float* win = KARG(7); const float* wgt = KARG(13);
        for (int idx = F.vcu * NWAVES * 64 + F.tid; idx < 4 * 128 * 1024; idx += F.G * NWAVES * 64) { const int dd = idx & 1023, cc = (idx >> 10) & 127, l = idx >> 17;
            const float* wi = win + ((size_t)l * 1024 + dd) * NIN + 1792; const float* wg = wgt + (size_t)l * 2048 + cc;
            const f32x4 a0 = *(const f32x4*)wi, a1 = *(const f32x4*)(wi + 4), a2 = *(const f32x4*)(wi + 8), a3 = *(const f32x4*)(wi + 12);
            float s = 0.f;
#pragma unroll
            for (int r = 0; r < 4; ++r) { s += a0[r] * wg[r * 128]; s += a1[r] * wg[(4 + r) * 128]; s += a2[r] * wg[(8 + r) * 128]; s += a3[r] * wg[(12 + r) * 128]; }
            if constexpr (G1_FP8) WIN8[(size_t)l * NPROJ * 1024 + (size_t)(C_GLA + GLA_W * (cc >> 5) + 192 + (cc & 31)) * 1024 + dd] = (unsigned char)(pg8::cvt_pk4_fp8(s * pg8::W13_8_SCALE, 0.f, 0.f, 0.f) & 0xffu);
            else WIN[(size_t)l * NPROJ * 1024 + (size_t)(C_GLA + GLA_W * (cc >> 5) + 192 + (cc & 31)) * 1024 + dd] = (bf16)f2bf(s); } }
    LAS float* scr = (LAS float*)(F.lds + RING_OFF + F.wave * 16384);
    const int nmod = F.G < 48 ? F.G : 48, mslot = F.G >= 128 ? 0 : 1, nslot = (F.vcu < nmod) ? mslot : 5, slot0 = (F.vcu < nmod) ? 5 * (F.G - nmod) + F.vcu : 5 * (F.vcu - nmod), NGW = (5 * (F.G - nmod) + mslot * nmod) * NWAVES;
    constexpr int I_IN = 16 * 100, I_OUT = 16 * 32, I_F13 = 16 * 88, I_F2 = 44 * 32, I_E13 = 16 * 112, I_E2 = 56 * 32;
    constexpr int NITEMS = 4 * I_IN + 4 * I_OUT + 4 * I_F13 + 2 * I_F2 + 32 * I_E13 + 16 * I_E2;
    bf16* WIN = (bf16*)(ws + WS_WIN); bf16* WOUT = (bf16*)(ws + WS_WOUT);
    for (int sl = 0; sl < nslot; ++sl)
    for (int it = (slot0 + sl) * NWAVES + F.wave; it < NITEMS; it += NGW) {
        int r = it;
        if (r < 4 * I_IN) { const int l = r / I_IN, q = r % I_IN, kb = q / 100, nb = q % 100; const float* W = KARG(7) + (size_t)l * 1024 * NIN; bf16* D = WIN + (size_t)l * NPROJ * 1024;
            int src = 32 * nb;
            if (nb >= 68) { const int hb = (nb - 68) >> 3, i = (nb - 68) & 7; src = 2064 + 256 * (i >> 1) + 64 * hb + 32 * (i & 1); }
            else if (nb >= 40) { const int hb = (nb - 40) / 7, i = (nb - 40) % 7; src = i == 0 ? 1280 + 32 * hb : i == 1 ? 1408 + 32 * hb : i < 4 ? 1536 + 64 * hb + 32 * (i - 2) : i < 6 ? 1808 + 64 * hb + 32 * (i - 4) : -1; }
            if (src >= 0) { if constexpr (G1_FP8) p0_item8(W, NIN, 64 * kb, src, ws + WS_WIN + (size_t)l * NPROJ * 1024, 1024, 32 * nb, scr, F.lane, pg8::W13_8_SCALE); else p0_item(W, NIN, 64 * kb, src, D, 1024, 32 * nb, 32, scr, F.lane); }
            continue; }
        r -= 4 * I_IN;
        if (r < 4 * I_OUT) { const int l = r / I_OUT, q = r % I_OUT, kb = q / 32, nb = q % 32; p0_item(KARG(8) + (size_t)l * 1024 * 1024, 1024, 64 * kb, 32 * nb, WOUT + (size_t)l * 1024 * 1024, 1024, 32 * nb, 32, scr, F.lane); continue; }
        r -= 4 * I_OUT;
        if (r < 4 * I_F13) { const int m = r / I_F13, q = r % I_F13, kb = q / 88, nb = q % 88, i = m & 1, up = m >> 1;
            if constexpr (G3_FP8) p0_item8((up ? KARG(19) : KARG(18)) + (size_t)i * 1024 * FF, FF, 64 * kb, 32 * nb, ws + WS_W13D + (size_t)i * 2 * FF * 1024, 1024, swi_row(32 * nb) + (up ? 128 : 0), scr, F.lane, (up ? 0.6931471805599453f : 1.4426950408889634f) * pg8::W13_8_SCALE);
            else p0_item((up ? KARG(19) : KARG(18)) + (size_t)i * 1024 * FF, FF, 64 * kb, 32 * nb, (bf16*)(ws + WS_W13D) + (size_t)i * 2 * FF * 1024, 1024, swi_row(32 * nb) + (up ? 128 : 0), 32, scr, F.lane, up ? 0.6931471805599453f : 1.4426950408889634f);
            continue; }
        r -= 4 * I_F13;
        if (r < 2 * I_F2) { const int i = r / I_F2, q = r % I_F2, kb = q / 32, nb = q % 32; if constexpr (G4_FP8) p0_item8(KARG(20) + (size_t)i * FF * 1024, 1024, 64 * kb, 32 * nb, ws + WS_W2D + (size_t)i * 1024 * FF, FF, 32 * nb, scr, F.lane, pg8::W2_8_SCALE);
            else p0_item(KARG(20) + (size_t)i * FF * 1024, 1024, 64 * kb, 32 * nb, (bf16*)(ws + WS_W2D) + (size_t)i * 1024 * FF, FF, 32 * nb, 32, scr, F.lane);
            continue; }
        r -= 2 * I_F2;
        if (r < 32 * I_E13) { const int m = r / I_E13, q = r % I_E13, kb = q / 112, nb = q % 112, le = m & 15, up = m >> 4;
            p0_item8((up ? KARG(23) : KARG(22)) + (size_t)le * 1024 * FFE, FFE, 64 * kb, 32 * nb, ws + WS_W13E + (size_t)(le >> 3) * W13E_LSTRIDE + (size_t)(le & 7) * 2 * FFE * 1024, 1024, swi_row(32 * nb) + (up ? 128 : 0), scr, F.lane, (up ? 0.6931471805599453f : 1.4426950408889634f) * pg8::W13_8_SCALE); continue; }
        r -= 32 * I_E13;
        { const int le = r / I_E2, q = r % I_E2, kb = q / 32, nb = q % 32; p0_item8(KARG(24) + (size_t)le * FFE * 1024, 1024, 64 * kb, 32 * nb, ws + WS_W2E + (size_t)le * 1024 * FFE, FFE, 32 * nb, scr, F.lane, pg8::W2_8_SCALE); }
    }
}

template <bool COMBINE, bool ROUTER, bool XF32, bool H8 = false>
__device__ __forceinline__ void norm_phase(Frame& F, const void* xin_, bf16* xout, const float* gain, const float* modl, int sh_off, int sc_off, const float* modprev, const float* router, int moe_idx) {
    unsigned char* ws = F.ws; bf16* H = (bf16*)(ws + WS_H); const bf16* YS = (const bf16*)(ws + WS_YS);
    int* RE = (int*)(ws + WS_RE); f32x2* RW = (f32x2*)(ws + WS_RW); const i32x2* RP = (const i32x2*)(ws + WS_RP);
    LAS float* wr = (LAS float*)(F.lds + RING_OFF);
    LAS unsigned* lcnt = (LAS unsigned*)(F.MISC + 16);
    if (ROUTER) {
        for (int idx = F.tid; idx < 8192; idx += NWAVES * 64) { const int d = idx >> 3, e = idx & 7, j = d >> 8, rem = d & 255, ln = rem >> 2, i = rem & 3; wr[((j * 4 + i) * 64 + ln) * 8 + e] = router[idx]; }
        if (F.tid < 8) lcnt[F.tid] = 0u;
        __syncthreads();
    }
    const int lane = F.lane;
    constexpr int UR = 2;
    for (int blk = F.vcu; blk < T / 256; blk += F.G) {
    const int b = blk >> 3;
    f32x4 ca[4], cb[4], gfr[4];
    {   const f32x4* g4 = (const f32x4*)gain; const f32x4* sc4 = (const f32x4*)(modl + (size_t)b * NMOD + sc_off); const f32x4* sh4 = (const f32x4*)(modl + (size_t)b * NMOD + sh_off);
#pragma unroll
        for (int j = 0; j < 4; ++j) { ca[j] = g4[64 * j + lane] * (sc4[64 * j + lane] + 1.0f); cb[j] = sh4[64 * j + lane]; gfr[j] = (f32x4){0.f, 0.f, 0.f, 0.f}; }
        if (COMBINE) { const f32x4* gf = (const f32x4*)(modprev + (size_t)b * NMOD + 5 * DM);
#pragma unroll
            for (int j = 0; j < 4; ++j) gfr[j] = gf[64 * j + lane]; }
    }
    const int mbase = blk * 256 + F.wave * 32;
    for (int i0 = 0; i0 < 32; i0 += UR) {
        f32x4 v[UR][4]; f32x4 ya[UR][4], yc[UR][4]; f32x2 ww[UR];
#pragma unroll
        for (int u = 0; u < UR; ++u) { const int m = mbase + i0 + u;
            if (XF32) { const f32x4* xr = (const f32x4*)((const float*)xin_ + (size_t)m * DM);
#pragma unroll
                for (int j = 0; j < 4; ++j) v[u][j] = xr[64 * j + lane]; }
            else { const bf16* xr = (const bf16*)xin_ + (size_t)m * DM;
#pragma unroll
                for (int j = 0; j < 4; ++j) v[u][j] = ld_bf4(xr + 4 * (64 * j + lane)); }
            if (COMBINE) { const i32x2 pp = RP[m]; ww[u] = RW[m];
                const bf16* y0 = YS + (size_t)pp.x * DM; const bf16* y1 = YS + (size_t)pp.y * DM;
#pragma unroll
                for (int j = 0; j < 4; ++j) { ya[u][j] = ld_bf4(y0 + 4 * (64 * j + lane)); yc[u][j] = ld_bf4(y1 + 4 * (64 * j + lane)); } }
        }
        asm volatile("" ::: "memory");
#pragma unroll
        for (int u = 0; u < UR; ++u) { const int m = mbase + i0 + u;
            if (COMBINE) { bf16* xo = xout + (size_t)m * DM;
#pragma unroll
                for (int j = 0; j < 4; ++j) { v[u][j] = v[u][j] + gfr[j] * (ya[u][j] * ww[u].x + yc[u][j] * ww[u].y); st_bf4(xo + 4 * (64 * j + lane), v[u][j]); v[u][j] = ld_bf4_reg(v[u][j]); } }
            if (XF32) { bf16* xo = xout + (size_t)m * DM;
#pragma unroll
                for (int j = 0; j < 4; ++j) { st_bf4(xo + 4 * (64 * j + lane), v[u][j]); v[u][j] = ld_bf4_reg(v[u][j]); } }
            float ss = 0.f;
#pragma unroll
            for (int j = 0; j < 4; ++j) ss += (v[u][j][0] * v[u][j][0] + v[u][j][1] * v[u][j][1]) + (v[u][j][2] * v[u][j][2] + v[u][j][3] * v[u][j][3]);
            const float rstd = rsqrtf(wave_sum(ss) * (1.0f / DM) + EPS);
            bf16* ho = H + (size_t)m * DM;
#pragma unroll
            for (int j = 0; j < 4; ++j) { v[u][j] = v[u][j] * rstd * ca[j] + cb[j];
                if (H8) { const f32x4 q = v[u][j] * (1.0f / pg8::W13_8_SCALE); *(unsigned*)((unsigned char*)H + (size_t)m * DM + 4 * (64 * j + lane)) = pg8::cvt_pk4_fp8(q[0], q[1], q[2], q[3]); }
                else st_bf4(ho + 4 * (64 * j + lane), v[u][j]); }
            if (ROUTER) {
                float lg[8];
#pragma unroll
                for (int e = 0; e < 8; ++e) lg[e] = 0.f;
#pragma unroll
                for (int j = 0; j < 4; ++j)
#pragma unroll
                    for (int i = 0; i < 4; ++i) { const LAS float* wp = wr + ((j * 4 + i) * 64 + lane) * 8; const f32x4 w0 = *(const LAS f32x4*)wp, w1 = *(const LAS f32x4*)(wp + 4); const float y = v[u][j][i];
                        lg[0] += y * w0[0]; lg[1] += y * w0[1]; lg[2] += y * w0[2]; lg[3] += y * w0[3]; lg[4] += y * w1[0]; lg[5] += y * w1[1]; lg[6] += y * w1[2]; lg[7] += y * w1[3]; }
#pragma unroll
                for (int e = 0; e < 8; ++e) lg[e] = wave_sum(lg[e]);
                if (lane == 0) {
                    int e0 = 0; float v0 = lg[0];
#pragma unroll
                    for (int e = 1; e < 8; ++e) if (lg[e] > v0) { v0 = lg[e]; e0 = e; }
                    int e1 = -1; float v1 = -3.0e38f;
#pragma unroll
                    for (int e = 0; e < 8; ++e) if (e != e0 && lg[e] > v1) { v1 = lg[e]; e1 = e; }
                    const float w0 = 1.0f / (1.0f + __expf(v1 - v0));
                    RE[m] = e0 | (e1 << 8); RW[m] = (f32x2){w0 * (1.0f / pg8::W2_8_SCALE), (1.0f - w0) * (1.0f / pg8::W2_8_SCALE)};
                    __hip_atomic_fetch_add(lcnt + e0, 1u, __ATOMIC_RELAXED, __HIP_MEMORY_SCOPE_WORKGROUP); __hip_atomic_fetch_add(lcnt + e1, 1u, __ATOMIC_RELAXED, __HIP_MEMORY_SCOPE_WORKGROUP);
                }
            }
        }
    }
    }
    if (ROUTER) {
        __syncthreads();
        if (F.tid < 8) __hip_atomic_fetch_add(F.ctl + CW_MOE + moe_idx * 64 + F.tid, lcnt[F.tid], RLX_AGENT);
    }
}
__device__ __forceinline__ void final_phase(Frame& F, const float* modprev, const bf16* xb) {
    unsigned char* ws = F.ws; const bf16* YS = (const bf16*)(ws + WS_YS); const f32x2* RW = (const f32x2*)(ws + WS_RW); const i32x2* RP = (const i32x2*)(ws + WS_RP);
    const int lane = F.lane;
    const f32x4* g4 = (const f32x4*)KARG(4);
    f32x4 gn[4];
#pragma unroll
    for (int j = 0; j < 4; ++j) gn[j] = g4[64 * j + lane];
    for (int blk = F.vcu; blk < T / 256; blk += F.G) {
        const int b = blk >> 3; const f32x4* gf = (const f32x4*)(modprev + (size_t)b * NMOD + 5 * DM);
        f32x4 gfr[4];
#pragma unroll
        for (int j = 0; j < 4; ++j) gfr[j] = gf[64 * j + lane];
        const int mbase = blk * 256 + F.wave * 32;
        for (int i0 = 0; i0 < 32; i0 += 2) {
            f32x4 v[2][4], ya[2][4], yc[2][4]; f32x2 ww[2];
#pragma unroll
            for (int u = 0; u < 2; ++u) { const int m = mbase + i0 + u; const bf16* xr = xb + (size_t)m * DM;
                const i32x2 pp = RP[m]; ww[u] = RW[m]; const bf16* y0 = YS + (size_t)pp.x * DM; const bf16* y1 = YS + (size_t)pp.y * DM;
#pragma unroll
                for (int j = 0; j < 4; ++j) { v[u][j] = ld_bf4(xr + 4 * (64 * j + lane)); ya[u][j] = ld_bf4(y0 + 4 * (64 * j + lane)); yc[u][j] = ld_bf4(y1 + 4 * (64 * j + lane)); } }
            asm volatile("" ::: "memory");
#pragma unroll
            for (int u = 0; u < 2; ++u) { const int m = mbase + i0 + u; f32x4* xr = (f32x4*)(F.out + (size_t)m * DM);
                float ss = 0.f;
#pragma unroll
                for (int j = 0; j < 4; ++j) { v[u][j] = v[u][j] + gfr[j] * (ya[u][j] * ww[u].x + yc[u][j] * ww[u].y);
                    ss += (v[u][j][0] * v[u][j][0] + v[u][j][1] * v[u][j][1]) + (v[u][j][2] * v[u][j][2] + v[u][j][3] * v[u][j][3]); }
                const float rstd = rsqrtf(wave_sum(ss) * (1.0f / DM) + EPS);
#pragma unroll
                for (int j = 0; j < 4; ++j) xr[64 * j + lane] = v[u][j] * rstd * gn[j];
            }
        }
    }
}

__device__ __forceinline__ unsigned r256(unsigned x) { return (x + 255u) & ~255u; }
__device__ __forceinline__ void route_phase(Frame& F, int moe_idx) {
    unsigned char* ws = F.ws; const int* RE = (const int*)(ws + WS_RE); i32x2* RP = (i32x2*)(ws + WS_RP); int* RM = (int*)(ws + WS_RM);
    LAS unsigned* lcnt = (LAS unsigned*)(F.MISC + 16); LAS unsigned* lbase = (LAS unsigned*)(F.MISC + 24);
    gu32* gcnt = F.ctl + CW_MOE + moe_idx * 64; gu32* gcur = gcnt + 16;
    unsigned cn[8];
#pragma unroll
    for (int e = 0; e < 8; ++e) cn[e] = __hip_atomic_load(gcnt + e, RLX_AGENT);
    for (int blk = F.vcu; blk < T / 256; blk += F.G) {
        if (F.tid < 8) lcnt[F.tid] = 0u;
        __syncthreads();
        int e0 = 0, e1 = 0; unsigned l0 = 0, l1 = 0; const int tok = blk * 256 + F.tid;
        if (F.tid < 256) { const int ee = RE[tok]; e0 = ee & 255; e1 = ee >> 8;
            l0 = __hip_atomic_fetch_add(lcnt + e0, 1u, __ATOMIC_RELAXED, __HIP_MEMORY_SCOPE_WORKGROUP); l1 = __hip_atomic_fetch_add(lcnt + e1, 1u, __ATOMIC_RELAXED, __HIP_MEMORY_SCOPE_WORKGROUP); }
        __syncthreads();
        if (F.tid < 8) lbase[F.tid] = __hip_atomic_fetch_add(gcur + F.tid, lcnt[F.tid], RLX_AGENT);
        __syncthreads();
        if (F.tid < 256) {
            unsigned o0 = 0, o1 = 0;
#pragma unroll
            for (int j = 0; j < 7; ++j) { o0 += (j < e0) ? r256(cn[j]) : 0u; o1 += (j < e1) ? r256(cn[j]) : 0u; }
            const int p0 = (int)(o0 + lbase[e0] + l0), p1 = (int)(o1 + lbase[e1] + l1);
            RM[p0] = tok; RM[p1] = tok; RP[tok] = (i32x2){p0, p1};
        }
        __syncthreads();
    }
    if (F.vcu < 8) {
        unsigned o = 0;
#pragma unroll
        for (int j = 0; j < 7; ++j) o += (j < F.vcu) ? r256(cn[j]) : 0u;
        unsigned mine = 0;
#pragma unroll
        for (int j = 0; j < 8; ++j) mine = (j == F.vcu) ? cn[j] : mine;
        for (unsigned p = mine + F.tid; p < r256(mine); p += NWAVES * 64) RM[o + p] = 0;
    }
}

__device__ __forceinline__ void conv_item(const bf16* PROJ, bf16* MIX, const float* cw, int idx) {
    const int t = idx >> 5, c8 = (idx & 31) * 8, tin = t & (SEQ - 1);
    const bf16* pr = PROJ + (size_t)t * NPROJ;
    float z[3][8];
#pragma unroll
    for (int d = 0; d < 3; ++d) {
        if (tin >= d) { const bf16* q = pr - (size_t)d * NPROJ; const f32x4 a0 = ld_bf4(q + C_CC + c8), a1 = ld_bf4(q + C_CC + c8 + 4), x0 = ld_bf4(q + C_CX + c8), x1 = ld_bf4(q + C_CX + c8 + 4);
#pragma unroll
            for (int i = 0; i < 4; ++i) { z[d][i] = a0[i] * x0[i]; z[d][4 + i] = a1[i] * x1[i]; } }
        else {
#pragma unroll
            for (int i = 0; i < 8; ++i) z[d][i] = 0.f; }
    }
    const f32x4 b0 = ld_bf4(pr + C_CB + c8), b1 = ld_bf4(pr + C_CB + c8 + 4);
    float y[8];
#pragma unroll
    for (int i = 0; i < 8; ++i) { const float bb = i < 4 ? b0[i & 3] : b1[i & 3]; y[i] = bb * (cw[c8 + i] * z[2][i] + cw[256 + c8 + i] * z[1][i] + cw[512 + c8 + i] * z[0][i]); }
    v4u o; o.x = pg8::cvt_pk_bf16(y[0], y[1]); o.y = pg8::cvt_pk_bf16(y[2], y[3]); o.z = pg8::cvt_pk_bf16(y[4], y[5]); o.w = pg8::cvt_pk_bf16(y[6], y[7]);
    *(v4u*)(MIX + (size_t)t * DM + c8) = o;
}
__device__ __forceinline__ void conv_phase(Frame& F, int layer) {
    const bf16* PROJ = (const bf16*)(F.ws + WS_PROJ); bf16* MIX = (bf16*)(F.ws + WS_MIX); const float* cw = KARG(9) + layer * 768;
    for (int idx = F.vcu * NWAVES * 64 + F.tid; idx < T * 32; idx += F.G * NWAVES * 64) conv_item(PROJ, MIX, cw, idx);
}

__device__ __forceinline__ void sgu_unit(Frame& F, int layer, int b, int ch) {
    constexpr int LP = 136, OP = 72;
    LAS bf16* vnT = (LAS bf16*)(F.lds + RING_OFF); LAS bf16* Wb = (LAS bf16*)(F.lds + RING_OFF + 256 * LP * 2); LAS bf16* OT = (LAS bf16*)(F.lds + RING_OFF + 256 * LP * 2 + 128 * LP * 2);
    static_assert(256 * LP * 2 + 128 * LP * 2 + 128 * OP * 2 <= RING_BYTES, "SGU LDS map");
    const bf16* PROJ = (const bf16*)(F.ws + WS_PROJ); bf16* MIX = (bf16*)(F.ws + WS_MIX);
    const size_t row0 = (size_t)b * SEQ + (size_t)ch * 128; const int lane = F.lane, w = F.wave, tid = F.tid;
    __syncthreads();
    const int wt = tid >> 2, wsq = (tid & 3) * 32;
    f32x4 wa[4], wc[4];
    { const float* wsrc = KARG(11) + ((size_t)(layer * 4) * 128 + wt) * 128 + wsq;
#pragma unroll
      for (int c8 = 0; c8 < 4; ++c8) { wa[c8] = *(const f32x4*)(wsrc + 8 * c8); wc[c8] = *(const f32x4*)(wsrc + 8 * c8 + 4); } }
    {
        const int s = 16 * w + (lane >> 2), q = lane & 3; const bf16* src = PROJ + (row0 + s) * NPROJ + C_SV + 64 * q;
        v4u raw[8];
#pragma unroll
        for (int i = 0; i < 8; ++i) raw[i] = *(const v4u*)(src + 8 * i);
        float x[64]; float sm = 0.f, sq = 0.f;
#pragma unroll
        for (int i = 0; i < 8; ++i) { x[8 * i] = bflo(raw[i].x); x[8 * i + 1] = bfhi(raw[i].x); x[8 * i + 2] = bflo(raw[i].y); x[8 * i + 3] = bfhi(raw[i].y); x[8 * i + 4] = bflo(raw[i].z); x[8 * i + 5] = bfhi(raw[i].z); x[8 * i + 6] = bflo(raw[i].w); x[8 * i + 7] = bfhi(raw[i].w); }
#pragma unroll
        for (int i = 0; i < 64; ++i) { sm += x[i]; sq += x[i] * x[i]; }
        sm += __shfl_xor(sm, 1); sq += __shfl_xor(sq, 1); sm += __shfl_xor(sm, 2); sq += __shfl_xor(sq, 2);
        const float mu = sm * (1.0f / 256.0f), var = fmaxf(sq * (1.0f / 256.0f) - mu * mu, 0.f), rstd = rsqrtf(var + EPS);
        const float* gp = KARG(10) + layer * 256 + 64 * q;
#pragma unroll
        for (int i = 0; i < 64; ++i) vnT[(64 * q + i) * LP + s] = (bf16)f2bf((x[i] - mu) * rstd * gp[i]);
    }
    const int et = tid >> 2, edq = tid & 3;
    for (int hh = 0; hh < 4; ++hh) {
        LDS_BARRIER();
        const bf16* sup = PROJ + (row0 + et) * NPROJ + C_SU + hh * 64 + 16 * edq;
        const v4u su0 = *(const v4u*)sup, su1 = *(const v4u*)(sup + 8);
        {   const int t = wt, sq = wsq;
#pragma unroll
            for (int c8 = 0; c8 < 4; ++c8) { const f32x4 a = wa[c8], c = wc[c8]; float f[8] = {a[0], a[1], a[2], a[3], c[0], c[1], c[2], c[3]};
#pragma unroll
                for (int i = 0; i < 8; ++i) if (sq + 8 * c8 + i > t) f[i] = 0.f;
                v4u o; o.x = pk2(f[0], f[1]); o.y = pk2(f[2], f[3]); o.z = pk2(f[4], f[5]); o.w = pk2(f[6], f[7]);
                *(LAS v4u*)(Wb + t * LP + sq + 8 * c8) = o; }
            if (hh < 3) { const float* wsrc = KARG(11) + ((size_t)(layer * 4 + hh + 1) * 128 + wt) * 128 + wsq;
#pragma unroll
                for (int c8 = 0; c8 < 4; ++c8) { wa[c8] = *(const f32x4*)(wsrc + 8 * c8); wc[c8] = *(const f32x4*)(wsrc + 8 * c8 + 4); } } }
        LDS_BARRIER();
        f32x4 acc[4];
#pragma unroll
        for (int nt = 0; nt < 4; ++nt) acc[nt] = (f32x4){0.f, 0.f, 0.f, 0.f};
        for (int ks = 0; ks < 4; ++ks) { if (32 * ks > 16 * w + 15) break;
            const bf16x8 a = *(const LAS bf16x8*)(Wb + (16 * w + (lane & 15)) * LP + 32 * ks + 8 * (lane >> 4));
#pragma unroll
            for (int nt = 0; nt < 4; ++nt) { const bf16x8 bb = *(const LAS bf16x8*)(vnT + (hh * 64 + 16 * nt + (lane & 15)) * LP + 32 * ks + 8 * (lane >> 4));
                acc[nt] = __builtin_amdgcn_mfma_f32_16x16x32_bf16(a, bb, acc[nt], 0, 0, 0); } }
        const float* sb = KARG(12) + (size_t)(layer * 4 + hh) * 128 + 16 * w + 4 * (lane >> 4);
        const f32x4 sb4 = *(const f32x4*)sb;
#pragma unroll
        for (int nt = 0; nt < 4; ++nt)
#pragma unroll
            for (int r = 0; r < 4; ++r) OT[(16 * w + 4 * (lane >> 4) + r) * OP + 16 * nt + (lane & 15)] = (bf16)f2bf(acc[nt][r] + sb4[r]);
        LDS_BARRIER();
        {   const v4u m0 = *(const LAS v4u*)(OT + et * OP + 16 * edq), m1 = *(const LAS v4u*)(OT + et * OP + 16 * edq + 8);
            v4u o0, o1;
            o0.x = pg8::cvt_pk_bf16(bflo(su0.x) * bflo(m0.x), bfhi(su0.x) * bfhi(m0.x)); o0.y = pg8::cvt_pk_bf16(bflo(su0.y) * bflo(m0.y), bfhi(su0.y) * bfhi(m0.y));
            o0.z = pg8::cvt_pk_bf16(bflo(su0.z) * bflo(m0.z), bfhi(su0.z) * bfhi(m0.z)); o0.w = pg8::cvt_pk_bf16(bflo(su0.w) * bflo(m0.w), bfhi(su0.w) * bfhi(m0.w));
            o1.x = pg8::cvt_pk_bf16(bflo(su1.x) * bflo(m1.x), bfhi(su1.x) * bfhi(m1.x)); o1.y = pg8::cvt_pk_bf16(bflo(su1.y) * bflo(m1.y), bfhi(su1.y) * bfhi(m1.y));
            o1.z = pg8::cvt_pk_bf16(bflo(su1.z) * bflo(m1.z), bfhi(su1.z) * bfhi(m1.z)); o1.w = pg8::cvt_pk_bf16(bflo(su1.w) * bflo(m1.w), bfhi(su1.w) * bfhi(m1.w));
            bf16* mp = MIX + (row0 + et) * DM + 256 + hh * 64 + 16 * edq;
            *(v4u*)mp = o0; *(v4u*)(mp + 8) = o1; }
    }
}

typedef short v4i16_t __attribute__((ext_vector_type(4)));
constexpr int RM_PB = 144;
constexpr int RM_QD = 0, RM_KD = 18432, RM_QB = 36864, RM_KU = 55296, RM_V = 73728, RM_DEC = 92160, RM_O = 94208, RM_OP = 68;
static_assert(RM_O + 128 * RM_OP * 4 <= RING_BYTES, "recurrence LDS map");
__device__ __forceinline__ bf16x8 mk_frag(unsigned a, unsigned b, unsigned c, unsigned d) { return __builtin_bit_cast(bf16x8, (v4u){a, b, c, d}); }
template <bool GLA>
__device__ __forceinline__ void recur_mfma(Frame& F, int layer, int b, int hh) {
    constexpr int KD = GLA ? 32 : 64, NKT = KD / 16, NKS = KD / 32;
    LAS unsigned char* L = F.lds + RING_OFF;
    const bf16* PROJ = (const bf16*)(F.ws + WS_PROJ); bf16* MIX = (bf16*)(F.ws + WS_MIX);
    const int tid = F.tid, lane = F.lane, w = F.wave;
    const int li = lane & 15, kq = lane >> 4;
    float lbk = 0.f, bgk = 0.f;
    const int pk = GLA ? (lane & 31) : lane, phalf = GLA ? (lane >> 5) : 0;
    if (!GLA) lbk = ((const float*)(F.ws + WS_LB))[layer * 256 + hh * 64 + pk];
    else bgk = KARG(14)[layer * 128 + hh * 32 + pk];
    const int etok = tid >> 2, eq = tid & 3;
    const float* cwp = KARG(9) + layer * 768;
    f32x4 ng[4];
    { const float* ngp = (GLA ? KARG(15) : KARG(17)) + layer * 64 + 16 * eq;
#pragma unroll
      for (int i = 0; i < 4; ++i) ng[i] = *(const f32x4*)(ngp + 4 * i); }
    f32x4 S[NKT];
#pragma unroll
    for (int kt = 0; kt < NKT; ++kt) S[kt] = (f32x4){0.f, 0.f, 0.f, 0.f};
    const int hb = GLA ? C_GLA + GLA_W * hh : C_HGR + HGR_W * hh, c_q = hb, c_k = hb + (GLA ? 32 : 64), c_v = hb + (GLA ? 64 : 128), c_g = hb + (GLA ? 128 : 192), c_z = hb + 192;
    __syncthreads();
    constexpr int NJ = GLA ? 8 : 16;
    const int trow = 16 * w + 8 * phalf;
    const int vr = tid >> 2, vp = tid & 3;
    constexpr int NQ = GLA ? 1 : 2, PSH = GLA ? 2 : 3;
    v4u qa[NQ], ka[NQ], za, va0, va1, gn0, gn1, gc0, gc1; za = (v4u){0u, 0u, 0u, 0u};
#define RM_LOAD_RAW(T0) do { const size_t rb_ = (size_t)b * SEQ + (T0); \
        _Pragma("unroll") for (int i_ = 0; i_ < NQ; ++i_) { const int p_ = tid + 512 * i_, row_ = p_ >> PSH, pc_ = p_ & ((1 << PSH) - 1); const bf16* s_ = PROJ + (rb_ + row_) * NPROJ + 8 * pc_; \
            qa[i_] = *(const v4u*)(s_ + c_q); ka[i_] = *(const v4u*)(s_ + c_k); if (GLA) za = *(const v4u*)(s_ + c_z); } \
        { const bf16* s_ = PROJ + (rb_ + vr) * NPROJ + c_v + 16 * vp; va0 = *(const v4u*)s_; va1 = *(const v4u*)(s_ + 8); } \
        { const bf16* g_ = PROJ + (rb_ + etok) * NPROJ + c_g + 16 * eq; gn0 = *(const v4u*)g_; gn1 = *(const v4u*)(g_ + 8); } } while (0)
    RM_LOAD_RAW(0);
    asm volatile("" ::: "memory");
    for (int t0 = 0; t0 < SEQ; t0 += 128) {
        const size_t rowbase = (size_t)b * SEQ + t0;
        *(LAS v4u*)(L + RM_V + vr * RM_PB + vp * 32) = va0; *(LAS v4u*)(L + RM_V + vr * RM_PB + vp * 32 + 16) = va1;
#pragma unroll
        for (int i = 0; i < NQ; ++i) { const int p = tid + 512 * i, row = p >> PSH, pc = p & ((1 << PSH) - 1);
            *(LAS v4u*)(L + RM_QD + row * RM_PB + pc * 16) = qa[i]; *(LAS v4u*)(L + RM_KD + row * RM_PB + pc * 16) = ka[i]; if (GLA) *(LAS v4u*)(L + RM_QB + row * RM_PB + pc * 16) = za; }
        gc0 = gn0; gc1 = gn1;
        if (t0 + 128 < SEQ) { RM_LOAD_RAW(t0 + 128); }
        asm volatile("" ::: "memory");
        LDS_BARRIER();
        float qv[NJ], kv[NJ], bb[NJ];
        {   const LAS bf16* rq = (const LAS bf16*)(L + RM_QD + trow * RM_PB) + pk; const LAS bf16* rk = (const LAS bf16*)(L + RM_KD + trow * RM_PB) + pk; const LAS bf16* rz = (const LAS bf16*)(L + RM_QB + trow * RM_PB) + pk;
            unsigned short qr[NJ], kr[NJ], zr[GLA ? NJ : 1];
#pragma unroll
            for (int j = 0; j < NJ; ++j) { qr[j] = rq[j * (RM_PB / 2)]; kr[j] = rk[j * (RM_PB / 2)]; if (GLA) zr[j] = rz[j * (RM_PB / 2)]; }
#pragma unroll
            for (int j = 0; j < NJ; ++j) {
                if (!GLA) { qv[j] = bflo((unsigned)qr[j]); const float fl = bflo((unsigned)kr[j]);
                    const float f = fmaxf(lbk + (1.0f - lbk) * sigmoid_f(fl), 1e-30f); kv[j] = 1.0f - f; bb[j] = __logf(f); }
                else { qv[j] = bflo((unsigned)qr[j]) * 0.17677669529663687f; kv[j] = bflo((unsigned)kr[j]);
                    bb[j] = logsigmoid_f(bflo((unsigned)zr[GLA ? j : 0]) + bgk) * 0.0625f; }
            }
        }
#pragma unroll
        for (int j = 1; j < NJ; ++j) bb[j] += bb[j - 1];
        float bref, blast;
        if (!GLA) { bref = bb[8]; blast = bb[15]; }
        else { const float lowtot = __shfl_xor(bb[7], 32);
            if (phalf) {
#pragma unroll
                for (int j = 0; j < NJ; ++j) bb[j] += lowtot; }
            const float x0 = bb[0], y0 = __shfl_xor(x0, 32), x7 = bb[7], y7 = __shfl_xor(x7, 32);
            bref = phalf ? x0 : y0; blast = phalf ? x7 : y7; }
        {   const float E = __expf(bref), Gm = __expf(blast - bref);
            LAS bf16* qd = (LAS bf16*)(L + RM_QD + trow * RM_PB) + pk; LAS bf16* kd = (LAS bf16*)(L + RM_KD + trow * RM_PB) + pk;
            LAS bf16* qb = (LAS bf16*)(L + RM_QB + trow * RM_PB) + pk; LAS bf16* ku = (LAS bf16*)(L + RM_KU + trow * RM_PB) + pk;
#pragma unroll
            for (int j = 0; j < NJ; ++j) { const float e1 = __expf(bb[j] - bref), r1 = __builtin_amdgcn_rcpf(e1), a = qv[j] * e1, c = kv[j] * r1;
                const unsigned pa = pg8::cvt_pk_bf16(a, a * E), pc = pg8::cvt_pk_bf16(c, c * Gm);
                qd[j * (RM_PB / 2)] = (bf16)(pa & 0xffffu); qb[j * (RM_PB / 2)] = (bf16)(pa >> 16); kd[j * (RM_PB / 2)] = (bf16)(pc & 0xffffu); ku[j * (RM_PB / 2)] = (bf16)(pc >> 16); }
            if (phalf == 0) ((LAS float*)(L + RM_DEC))[w * 64 + pk] = __expf(blast);
        }
        LDS_BARRIER();
        if (w < 4) {
            const int v0 = 16 * w;
            const int q4 = li >> 2, p4 = li & 3;
#pragma unroll 2
            for (int c = 0; c < 8; ++c) {
                const int r0 = 16 * c;
                f32x4 pt = (f32x4){0.f, 0.f, 0.f, 0.f};
#pragma unroll
                for (int s = 0; s < NKS; ++s) { const bf16x8 a = *(const LAS bf16x8*)(L + RM_KD + (r0 + li) * RM_PB + (32 * s + 8 * kq) * 2), bq = *(const LAS bf16x8*)(L + RM_QD + (r0 + li) * RM_PB + (32 * s + 8 * kq) * 2);
                    pt = __builtin_amdgcn_mfma_f32_16x16x32_bf16(a, bq, pt, 0, 0, 0); }
#pragma unroll
                for (int r = 0; r < 4; ++r) if (4 * kq + r > li) pt[r] = 0.f;
                const bf16x8 pfrag = mk_frag(pg8::cvt_pk_bf16(pt[0], pt[1]), pg8::cvt_pk_bf16(pt[2], pt[3]), 0u, 0u);
                const v4i16_t tv = __builtin_amdgcn_ds_read_tr16_b64_v4i16((LAS v4i16_t*)(L + RM_V + (r0 + 4 * kq + q4) * RM_PB + (v0 + 4 * p4) * 2));
                const u32x2 tv2 = __builtin_bit_cast(u32x2, tv);
                const bf16x8 vfrag = mk_frag(tv2.x, tv2.y, 0u, 0u);
                f32x4 o = __builtin_amdgcn_mfma_f32_16x16x32_bf16(pfrag, vfrag, (f32x4){0.f, 0.f, 0.f, 0.f}, 0, 0, 0);
#pragma unroll
                for (int s = 0; s < NKS; ++s) { const LAS unsigned char* qp = L + RM_QB + (r0 + li) * RM_PB + (32 * s + 4 * kq) * 2; const u32x2 lo = *(const LAS u32x2*)qp, hi = *(const LAS u32x2*)(qp + 32);
                    const bf16x8 a = mk_frag(lo.x, lo.y, hi.x, hi.y);
                    const bf16x8 sb = mk_frag(pg8::cvt_pk_bf16(S[2 * s][0], S[2 * s][1]), pg8::cvt_pk_bf16(S[2 * s][2], S[2 * s][3]), pg8::cvt_pk_bf16(S[2 * s + 1][0], S[2 * s + 1][1]), pg8::cvt_pk_bf16(S[2 * s + 1][2], S[2 * s + 1][3]));
                    o = __builtin_amdgcn_mfma_f32_16x16x32_bf16(a, sb, o, 0, 0, 0); }
#pragma unroll
                for (int kt = 0; kt < NKT; ++kt) { const v4i16_t tk = __builtin_amdgcn_ds_read_tr16_b64_v4i16((LAS v4i16_t*)(L + RM_KU + (r0 + 4 * kq + q4) * RM_PB + (16 * kt + 4 * p4) * 2));
                    const u32x2 tk2 = __builtin_bit_cast(u32x2, tk); const bf16x8 a = mk_frag(tk2.x, tk2.y, 0u, 0u);
                    const f32x4 d4 = *(const LAS f32x4*)(L + RM_DEC + (c * 64 + 16 * kt + 4 * kq) * 4);
                    S[kt] = __builtin_amdgcn_mfma_f32_16x16x32_bf16(a, vfrag, S[kt] * d4, 0, 0, 0); }
                LAS float* op = (LAS float*)(L + RM_O) + (r0 + 4 * kq) * RM_OP + v0 + li;
#pragma unroll
                for (int r = 0; r < 4; ++r) op[r * RM_OP] = o[r];
            }
        }
        else if (F.G == 256) {
            const int i0 = F.vcu * 8192 + (t0 >> 7) * 512 + (tid - 256);
            conv_item(PROJ, MIX, cwp, i0); conv_item(PROJ, MIX, cwp, i0 + 256);
        }
        LDS_BARRIER();
        {   const LAS float* op = (const LAS float*)(L + RM_O) + etok * RM_OP + 16 * eq;
            f32x4 ov[4]; float ss = 0.f;
#pragma unroll
            for (int i = 0; i < 4; ++i) { ov[i] = *(const LAS f32x4*)(op + 4 * i); ss += (ov[i][0] * ov[i][0] + ov[i][1] * ov[i][1]) + (ov[i][2] * ov[i][2] + ov[i][3] * ov[i][3]); }
            ss += __shfl_xor(ss, 1); ss += __shfl_xor(ss, 2);
            const float rstd = rsqrtf(ss * (1.0f / 64.0f) + EPS);
            const v4u g0 = gc0, g1 = gc1;
            const float gt[16] = {bflo(g0.x), bfhi(g0.x), bflo(g0.y), bfhi(g0.y), bflo(g0.z), bfhi(g0.z), bflo(g0.w), bfhi(g0.w), bflo(g1.x), bfhi(g1.x), bflo(g1.y), bfhi(g1.y), bflo(g1.z), bfhi(g1.z), bflo(g1.w), bfhi(g1.w)};
            float y[16];
#pragma unroll
            for (int i = 0; i < 16; ++i) y[i] = ov[i >> 2][i & 3] * rstd * ng[i >> 2][i & 3] * silu_f(gt[i]);
            v4u o0, o1; o0.x = pg8::cvt_pk_bf16(y[0], y[1]); o0.y = pg8::cvt_pk_bf16(y[2], y[3]); o0.z = pg8::cvt_pk_bf16(y[4], y[5]); o0.w = pg8::cvt_pk_bf16(y[6], y[7]);
            o1.x = pg8::cvt_pk_bf16(y[8], y[9]); o1.y = pg8::cvt_pk_bf16(y[10], y[11]); o1.z = pg8::cvt_pk_bf16(y[12], y[13]); o1.w = pg8::cvt_pk_bf16(y[14], y[15]);
            bf16* mp = MIX + (rowbase + etok) * DM + (GLA ? 512 : 768) + hh * 64 + 16 * eq;
            *(v4u*)mp = o0; *(v4u*)(mp + 8) = o1;
        }
    }
#undef RM_LOAD_RAW
    __syncthreads();
}
constexpr int RP_SET = 5 * 64 * RM_PB;
constexpr int RP_QD = 0, RP_KD = 64 * RM_PB, RP_QB = 2 * 64 * RM_PB, RP_KU = 3 * 64 * RM_PB, RP_V = 4 * 64 * RM_PB, RP_DEC = 2 * RP_SET, RP_O = RP_DEC + 2 * 4 * 64 * 4, RP_OSZ = 64 * RM_OP * 4;
static_assert(RP_O + 2 * RP_OSZ <= RING_BYTES, "recurrence LDS map");
static_assert(RP_O + 64 * RM_OP * 4 <= RING_BYTES, "pipelined recurrence LDS map");
template <bool GLA>
__device__ __forceinline__ void recur_pipe(Frame& F, int layer, int b, int hh, int var = 0) {
    constexpr int KD = GLA ? 32 : 64, NKT = KD / 16, NKS = KD / 32, NBLK = SEQ / 64;
    LAS unsigned char* L = F.lds + RING_OFF;
    const bf16* PROJ = (const bf16*)(F.ws + WS_PROJ); bf16* MIX = (bf16*)(F.ws + WS_MIX);
    const int tid = F.tid, lane = F.lane, w = F.wave;
    const bool prod = w >= 4; const int pw = w & 3, ptid = tid & 255;
    const int li = lane & 15, kq = lane >> 4;
    const int hb = GLA ? C_GLA + GLA_W * hh : C_HGR + HGR_W * hh, c_q = hb, c_k = hb + (GLA ? 32 : 64), c_v = hb + (GLA ? 64 : 128), c_g = hb + (GLA ? 128 : 192), c_z = hb + 192;
    const size_t seq0 = (size_t)b * SEQ;
    __syncthreads();
    if (prod) {
        float lbk = 0.f, bgk = 0.f;
        const int pk = GLA ? (lane & 31) : lane, phalf = GLA ? (lane >> 5) : 0;
        if (!GLA) lbk = ((const float*)(F.ws + WS_LB))[layer * 256 + hh * 64 + pk]; else bgk = KARG(14)[layer * 128 + hh * 32 + pk];
        constexpr int NJ = GLA ? 8 : 16, NQ = GLA ? 1 : 2, PSH = GLA ? 2 : 3;
        const int trow = 16 * pw + 8 * phalf;
        v4u qa[2][NQ], ka[2][NQ], za[2], va[2][2]; za[0] = (v4u){0u, 0u, 0u, 0u}; za[1] = za[0];
#define RP_LOAD(N, RS) do { const size_t rb_ = seq0 + (size_t)(N) * 64; \
            _Pragma("unroll") for (int i_ = 0; i_ < NQ; ++i_) { const int row_ = 16 * pw + 8 * i_ + (lane >> PSH), pc_ = lane & ((1 << PSH) - 1); const bf16* s_ = PROJ + (rb_ + row_) * NPROJ + 8 * pc_; \
                qa[RS][i_] = *(const v4u*)(s_ + c_q); ka[RS][i_] = *(const v4u*)(s_ + c_k); if (GLA) za[RS] = *(const v4u*)(s_ + c_z); } \
            _Pragma("unroll") for (int i_ = 0; i_ < 2; ++i_) { const int p_ = ptid + 256 * i_; va[RS][i_] = *(const v4u*)(PROJ + (rb_ + (p_ >> 3)) * NPROJ + c_v + 8 * (p_ & 7)); } } while (0)
#define RP_STAGE(SET, RS) do { LAS unsigned char* B_ = L + (SET) * RP_SET; \
            _Pragma("unroll") for (int i_ = 0; i_ < NQ; ++i_) { const int row_ = 16 * pw + 8 * i_ + (lane >> PSH), pc_ = lane & ((1 << PSH) - 1); \
                *(LAS v4u*)(B_ + RP_QD + row_ * RM_PB + pc_ * 16) = qa[RS][i_]; *(LAS v4u*)(B_ + RP_KD + row_ * RM_PB + pc_ * 16) = ka[RS][i_]; if (GLA) *(LAS v4u*)(B_ + RP_QB + row_ * RM_PB + pc_ * 16) = za[RS]; } \
            _Pragma("unroll") for (int i_ = 0; i_ < 2; ++i_) { const int p_ = ptid + 256 * i_; *(LAS v4u*)(B_ + RP_V + (p_ >> 3) * RM_PB + (p_ & 7) * 16) = va[RS][i_]; } } while (0)
#define RP_PREP(SET) do { LAS unsigned char* B_ = L + (SET) * RP_SET; \
            const LAS bf16* rq = (const LAS bf16*)(B_ + RP_QD + trow * RM_PB) + pk; const LAS bf16* rk = (const LAS bf16*)(B_ + RP_KD + trow * RM_PB) + pk; const LAS bf16* rz = (const LAS bf16*)(B_ + RP_QB + trow * RM_PB) + pk; \
            unsigned short qr[NJ], kr[NJ], zr[GLA ? NJ : 1]; float qv[NJ], kv[NJ], bb[NJ]; \
            _Pragma("unroll") for (int j = 0; j < NJ; ++j) { qr[j] = rq[j * (RM_PB / 2)]; kr[j] = rk[j * (RM_PB / 2)]; if (GLA) zr[j] = rz[j * (RM_PB / 2)]; } \
            _Pragma("unroll") for (int j = 0; j < NJ; ++j) { \
                if (!GLA) { qv[j] = bflo((unsigned)qr[j]); const float fl = bflo((unsigned)kr[j]); const float f = fmaxf(lbk + (1.0f - lbk) * sigmoid_f(fl), 1e-30f); kv[j] = 1.0f - f; bb[j] = __logf(f); } \
                else { qv[j] = bflo((unsigned)qr[j]) * 0.17677669529663687f; kv[j] = bflo((unsigned)kr[j]); bb[j] = logsigmoid_f(bflo((unsigned)zr[GLA ? j : 0]) + bgk) * 0.0625f; } } \
            _Pragma("unroll") for (int j = 1; j < NJ; ++j) bb[j] += bb[j - 1]; \
            float bref, blast; \
            if (!GLA) { bref = bb[GLA ? 0 : 8]; blast = bb[GLA ? 0 : 15]; } \
            else { const float lowtot = __shfl_xor(bb[7], 32); if (phalf) { _Pragma("unroll") for (int j = 0; j < NJ; ++j) bb[j] += lowtot; } \
                const float x0 = bb[0], y0 = __shfl_xor(x0, 32), x7 = bb[7], y7 = __shfl_xor(x7, 32); bref = phalf ? x0 : y0; blast = phalf ? x7 : y7; } \
            const float E = __expf(bref), Gm = __expf(blast - bref); \
            LAS bf16* qd = (LAS bf16*)(B_ + RP_QD + trow * RM_PB) + pk; LAS bf16* kd = (LAS bf16*)(B_ + RP_KD + trow * RM_PB) + pk; LAS bf16* qb = (LAS bf16*)(B_ + RP_QB + trow * RM_PB) + pk; LAS bf16* ku = (LAS bf16*)(B_ + RP_KU + trow * RM_PB) + pk; \
            _Pragma("unroll") for (int j = 0; j < NJ; ++j) { const float e1 = __expf(bb[j] - bref), r1 = __builtin_amdgcn_rcpf(e1), a = qv[j] * e1, c = kv[j] * r1; \
                const unsigned pa = pg8::cvt_pk_bf16(a, a * E), pc = pg8::cvt_pk_bf16(c, c * Gm); \
                qd[j * (RM_PB / 2)] = (bf16)(pa & 0xffffu); qb[j * (RM_PB / 2)] = (bf16)(pa >> 16); kd[j * (RM_PB / 2)] = (bf16)(pc & 0xffffu); ku[j * (RM_PB / 2)] = (bf16)(pc >> 16); } \
            if (phalf == 0) ((LAS float*)(L + RP_DEC))[((SET) * 4 + pw) * 64 + pk] = __expf(blast); } while (0)
        RP_LOAD(0, 0); RP_LOAD(1, 1); asm volatile("" ::: "memory");
        RP_STAGE(0, 0); RP_LOAD(2, 0); asm volatile("" ::: "memory");
        RP_PREP(0);
        LDS_BARRIER();
        for (int n = 0; n < NBLK; n += 2) {
            { RP_STAGE(1, 1); if (n + 3 < NBLK) { RP_LOAD(n + 3, 1); } asm volatile("" ::: "memory"); if (var != 2 && var != 5) { RP_PREP(1); } }
            LDS_BARRIER();
            if (n + 2 < NBLK) { RP_STAGE(0, 0); if (n + 4 < NBLK) { RP_LOAD(n + 4, 0); } asm volatile("" ::: "memory"); if (var != 2 && var != 5) { RP_PREP(0); } }
            LDS_BARRIER();
        }
#undef RP_LOAD
#undef RP_STAGE
#undef RP_PREP
    } else {
        const int etok = ptid >> 2, eq = ptid & 3;
        const float* cwp = KARG(9) + layer * 768;
        f32x4 ng[4];
        { const float* ngp = (GLA ? KARG(15) : KARG(17)) + layer * 64 + 16 * eq;
#pragma unroll
          for (int i = 0; i < 4; ++i) ng[i] = *(const f32x4*)(ngp + 4 * i); }
        f32x4 S[NKT];
#pragma unroll
        for (int kt = 0; kt < NKT; ++kt) S[kt] = (f32x4){0.f, 0.f, 0.f, 0.f};
        const int v0 = 16 * pw, q4 = li >> 2, p4 = li & 3;
        v4u gn0, gn1;
        { const bf16* g_ = PROJ + (seq0 + etok) * NPROJ + c_g + 16 * eq; gn0 = *(const v4u*)g_; gn1 = *(const v4u*)(g_ + 8); }
        const bool do_conv = (F.G == 256) && var != 1 && var != 5;
        const int cc8 = (ptid & 31) * 8;
        LAS float* cwl = (LAS float*)(F.lds + ROWTAB_OFF);
#pragma unroll
        for (int d_ = 0; d_ < 3; ++d_) cwl[d_ * 256 + ptid] = cwp[d_ * 256 + ptid];
        v4u craw[7];
        asm volatile("" ::: "memory");
        LDS_BARRIER();
        for (int n = 0; n <= NBLK; ++n) {
            if (n < NBLK) {
            if (do_conv) { const int t_ = (F.vcu * 8192 + n * 256 + ptid) >> 5, tin_ = t_ & (SEQ - 1); const bf16* pr_ = PROJ + (size_t)t_ * NPROJ + cc8;
#pragma unroll
                for (int d_ = 0; d_ < 3; ++d_) { if (tin_ >= d_) { craw[2 * d_] = *(const v4u*)(pr_ - (size_t)d_ * NPROJ + C_CC); craw[2 * d_ + 1] = *(const v4u*)(pr_ - (size_t)d_ * NPROJ + C_CX); } else { craw[2 * d_] = (v4u){0u, 0u, 0u, 0u}; craw[2 * d_ + 1] = (v4u){0u, 0u, 0u, 0u}; } }
                craw[6] = *(const v4u*)(pr_ + C_CB); }
            const LAS unsigned char* B = L + (n & 1) * RP_SET;
            if (var != 3 && var != 5) {
            f32x4 oi[4]; bf16x8 vf[4];
#pragma unroll
            for (int c = 0; c < 4; ++c) {
                const int r0 = 16 * c;
                f32x4 pt = (f32x4){0.f, 0.f, 0.f, 0.f};
#pragma unroll
                for (int s = 0; s < NKS; ++s) { const bf16x8 a = *(const LAS bf16x8*)(B + RP_KD + (r0 + li) * RM_PB + (32 * s + 8 * kq) * 2), bq = *(const LAS bf16x8*)(B + RP_QD + (r0 + li) * RM_PB + (32 * s + 8 * kq) * 2);
                    pt = __builtin_amdgcn_mfma_f32_16x16x32_bf16(a, bq, pt, 0, 0, 0); }
#pragma unroll
                for (int r = 0; r < 4; ++r) if (4 * kq + r > li) pt[r] = 0.f;
                const bf16x8 pfrag = mk_frag(pg8::cvt_pk_bf16(pt[0], pt[1]), pg8::cvt_pk_bf16(pt[2], pt[3]), 0u, 0u);
                const v4i16_t tv = __builtin_amdgcn_ds_read_tr16_b64_v4i16((LAS v4i16_t*)(B + RP_V + (r0 + 4 * kq + q4) * RM_PB + (v0 + 4 * p4) * 2));
                const u32x2 tv2 = __builtin_bit_cast(u32x2, tv);
                vf[c] = mk_frag(tv2.x, tv2.y, 0u, 0u);
                oi[c] = __builtin_amdgcn_mfma_f32_16x16x32_bf16(pfrag, vf[c], (f32x4){0.f, 0.f, 0.f, 0.f}, 0, 0, 0);
            }
#pragma unroll
            for (int c = 0; c < 4; ++c) {
                const int r0 = 16 * c;
                f32x4 o = oi[c];
#pragma unroll
                for (int s = 0; s < NKS; ++s) { const LAS unsigned char* qp = B + RP_QB + (r0 + li) * RM_PB + (32 * s + 4 * kq) * 2; const u32x2 lo = *(const LAS u32x2*)qp, hi = *(const LAS u32x2*)(qp + 32);
                    const bf16x8 a = mk_frag(lo.x, lo.y, hi.x, hi.y);
                    const bf16x8 sb = mk_frag(pg8::cvt_pk_bf16(S[2 * s][0], S[2 * s][1]), pg8::cvt_pk_bf16(S[2 * s][2], S[2 * s][3]), pg8::cvt_pk_bf16(S[2 * s + 1][0], S[2 * s + 1][1]), pg8::cvt_pk_bf16(S[2 * s + 1][2], S[2 * s + 1][3]));
                    o = __builtin_amdgcn_mfma_f32_16x16x32_bf16(a, sb, o, 0, 0, 0); }
#pragma unroll
                for (int kt = 0; kt < NKT; ++kt) { const v4i16_t tk = __builtin_amdgcn_ds_read_tr16_b64_v4i16((LAS v4i16_t*)(B + RP_KU + (r0 + 4 * kq + q4) * RM_PB + (16 * kt + 4 * p4) * 2));
                    const u32x2 tk2 = __builtin_bit_cast(u32x2, tk); const bf16x8 a = mk_frag(tk2.x, tk2.y, 0u, 0u);
                    const f32x4 d4 = *(const LAS f32x4*)(L + RP_DEC + (((n & 1) * 4 + c) * 64 + 16 * kt + 4 * kq) * 4);
                    S[kt] = __builtin_amdgcn_mfma_f32_16x16x32_bf16(a, vf[c], S[kt] * d4, 0, 0, 0); }
                oi[c] = o;
            }
#pragma unroll
            for (int c = 0; c < 4; ++c) { LAS float* op = (LAS float*)(L + RP_O + (n & 1) * RP_OSZ) + (16 * c + 4 * kq) * RM_OP + v0 + li;
#pragma unroll
                for (int r = 0; r < 4; ++r) op[r * RM_OP] = oi[c][r]; }
            }
            }
            const v4u g0 = gn0, g1 = gn1;
            if (n < NBLK && n > 0) { const bf16* g_ = PROJ + (seq0 + (size_t)n * 64 + etok) * NPROJ + c_g + 16 * eq; gn0 = *(const v4u*)g_; gn1 = *(const v4u*)(g_ + 8); }
            asm volatile("" ::: "memory");
            if (n > 0 && var != 4 && var != 5) {   const LAS float* op = (const LAS float*)(L + RP_O + ((n - 1) & 1) * RP_OSZ) + etok * RM_OP + 16 * eq;
                f32x4 ov[4]; float ss = 0.f;
#pragma unroll
                for (int i = 0; i < 4; ++i) { ov[i] = *(const LAS f32x4*)(op + 4 * i); ss += (ov[i][0] * ov[i][0] + ov[i][1] * ov[i][1]) + (ov[i][2] * ov[i][2] + ov[i][3] * ov[i][3]); }
                ss += __shfl_xor(ss, 1); ss += __shfl_xor(ss, 2);
                const float rstd = rsqrtf(ss * (1.0f / 64.0f) + EPS);
                const float gt[16] = {bflo(g0.x), bfhi(g0.x), bflo(g0.y), bfhi(g0.y), bflo(g0.z), bfhi(g0.z), bflo(g0.w), bfhi(g0.w), bflo(g1.x), bfhi(g1.x), bflo(g1.y), bfhi(g1.y), bflo(g1.z), bfhi(g1.z), bflo(g1.w), bfhi(g1.w)};
                float y[16];
#pragma unroll
                for (int i = 0; i < 16; ++i) y[i] = ov[i >> 2][i & 3] * rstd * ng[i >> 2][i & 3] * silu_f(gt[i]);
                v4u o0, o1; o0.x = pg8::cvt_pk_bf16(y[0], y[1]); o0.y = pg8::cvt_pk_bf16(y[2], y[3]); o0.z = pg8::cvt_pk_bf16(y[4], y[5]); o0.w = pg8::cvt_pk_bf16(y[6], y[7]);
                o1.x = pg8::cvt_pk_bf16(y[8], y[9]); o1.y = pg8::cvt_pk_bf16(y[10], y[11]); o1.z = pg8::cvt_pk_bf16(y[12], y[13]); o1.w = pg8::cvt_pk_bf16(y[14], y[15]);
                bf16* mp = MIX + (seq0 + (size_t)(n - 1) * 64 + etok) * DM + (GLA ? 512 : 768) + hh * 64 + 16 * eq;
                *(v4u*)mp = o0; *(v4u*)(mp + 8) = o1; }
            if (n < NBLK) {
                if (do_conv) { const int t_ = (F.vcu * 8192 + n * 256 + ptid) >> 5;
                    float y[8]; float cwr[3][8];
#pragma unroll
                    for (int d_ = 0; d_ < 3; ++d_) { const f32x4 c0 = *(const LAS f32x4*)(cwl + d_ * 256 + cc8), c1 = *(const LAS f32x4*)(cwl + d_ * 256 + cc8 + 4);
#pragma unroll
                        for (int i = 0; i < 4; ++i) { cwr[d_][i] = c0[i]; cwr[d_][4 + i] = c1[i]; } }
#pragma unroll
                    for (int i = 0; i < 8; ++i) { const int w_ = i >> 1;
                        const float z0 = (i & 1) ? bfhi(craw[0][w_]) * bfhi(craw[1][w_]) : bflo(craw[0][w_]) * bflo(craw[1][w_]);
                        const float z1 = (i & 1) ? bfhi(craw[2][w_]) * bfhi(craw[3][w_]) : bflo(craw[2][w_]) * bflo(craw[3][w_]);
                        const float z2 = (i & 1) ? bfhi(craw[4][w_]) * bfhi(craw[5][w_]) : bflo(craw[4][w_]) * bflo(craw[5][w_]);
                        const float bb = (i & 1) ? bfhi(craw[6][w_]) : bflo(craw[6][w_]);
                        y[i] = bb * (cwr[0][i] * z2 + cwr[1][i] * z1 + cwr[2][i] * z0); }
                    v4u o; o.x = pg8::cvt_pk_bf16(y[0], y[1]); o.y = pg8::cvt_pk_bf16(y[2], y[3]); o.z = pg8::cvt_pk_bf16(y[4], y[5]); o.w = pg8::cvt_pk_bf16(y[6], y[7]);
                    *(v4u*)(MIX + (size_t)t_ * DM + cc8) = o; }
                LDS_BARRIER();
            }
        }
    }
    __syncthreads();
}
#ifndef DUP_REC
#define DUP_REC 1
#endif
#ifndef DUP_SGU
#define DUP_SGU 1
#endif
#ifndef DUP_CONV
#define DUP_CONV 1
#endif
__device__ __forceinline__ void mixer_phase(Frame& F, int layer) {
#pragma unroll 1
    for (int rep = 0; rep < DUP_REC; ++rep)
    for (int u = F.vcu; u < 256; u += F.G) { const int bh = u >> 1, b = bh >> 2, hh = bh & 3;
#ifdef DUP_REC_ONLY
        if (rep + 1 < DUP_REC && (u & 1) != DUP_REC_ONLY) continue;
#endif
#ifdef REC_NOPIPE
        if (u & 1) recur_mfma<true>(F, layer, b, hh); else recur_mfma<false>(F, layer, b, hh); }
#else
        { int var = 0;
#ifdef REC_VAR
          if (rep + 1 < DUP_REC) var = REC_VAR;
#endif
          if (u & 1) recur_pipe<true>(F, layer, b, hh, var); else recur_pipe<false>(F, layer, b, hh, var); } }
#endif
#pragma unroll 1
    for (int rep = 0; rep < DUP_SGU; ++rep) {
        if (F.G == 256) {
            for (int i = 0; i < 2; ++i) { const int u = 2 * F.vcu + i; sgu_unit(F, layer, u >> 4, u & 15); }
        } else for (int u = F.vcu; u < NB * 16; u += F.G) sgu_unit(F, layer, u >> 4, u & 15);
    }
    if (F.G != 256) conv_phase(F, layer);
}


#ifndef DUP_P0
#define DUP_P0 1
#endif
#define EN_P0(x) do { _Pragma("unroll 1") for (int rep_ = 0; rep_ < DUP_P0; ++rep_) { x; } } while (0)
#ifndef DUP_NORM
#define DUP_NORM 1
#endif
#define EN_NORM(x) do { _Pragma("unroll 1") for (int rep_ = 0; rep_ < DUP_NORM; ++rep_) { x; } } while (0)
#ifndef DUP_NORM1
#define DUP_NORM1 1
#endif
#define EN_NORM1(x) do { _Pragma("unroll 1") for (int rep_ = 0; rep_ < DUP_NORM1; ++rep_) { x; } } while (0)
#ifndef DUP_MX
#define DUP_MX 1
#endif
#define EN_MX(x) do { _Pragma("unroll 1") for (int rep_ = 0; rep_ < DUP_MX; ++rep_) { x; } } while (0)
#ifndef DUP_FINAL
#define DUP_FINAL 1
#endif
#define EN_FINAL(x) do { _Pragma("unroll 1") for (int rep_ = 0; rep_ < DUP_FINAL; ++rep_) { x; } } while (0)
#ifndef DUP_G1
#define DUP_G1 1
#endif
#define EN_G1(x) do { _Pragma("unroll 1") for (int rep_ = 0; rep_ < DUP_G1; ++rep_) { x; } } while (0)
#ifndef DUP_G2
#define DUP_G2 1
#endif
#define EN_G2(x) do { _Pragma("unroll 1") for (int rep_ = 0; rep_ < DUP_G2; ++rep_) { x; } } while (0)
#ifndef DUP_G3
#define DUP_G3 1
#endif
#define EN_G3(x) do { _Pragma("unroll 1") for (int rep_ = 0; rep_ < DUP_G3; ++rep_) { x; } } while (0)
#ifndef DUP_G4
#define DUP_G4 1
#endif
#define EN_G4(x) do { _Pragma("unroll 1") for (int rep_ = 0; rep_ < DUP_G4; ++rep_) { x; } } while (0)
#ifndef DUP_UP
#define DUP_UP 1
#endif
#define EN_UP(x) do { _Pragma("unroll 1") for (int rep_ = 0; rep_ < DUP_UP; ++rep_) { x; } } while (0)
#ifndef DUP_DN
#define DUP_DN 1
#endif
#define EN_DN(x) do { _Pragma("unroll 1") for (int rep_ = 0; rep_ < DUP_DN; ++rep_) { x; } } while (0)
constexpr int N_STEPS = 1 + 4 * 5 + 2 * 2 + 2 * (1 + 1 + N_CHUNK) + 1;
struct Args { const float* in[25]; float* out; unsigned char* ws; int lo, hi; };
__global__ void __launch_bounds__(NWAVES * 64, 2) fwd_kernel(Args args) {
    extern __shared__ __attribute__((aligned(16))) unsigned char lds[];
    Frame F;
    F.lds = (LAS unsigned char*)lds; F.MISC = (volatile LAS unsigned*)(F.lds + LDSCTL_OFF);
    F.tid = threadIdx.x; F.lane = F.tid & 63; F.wave = __builtin_amdgcn_readfirstlane(F.tid >> 6);
    F.G = gridDim.x; { const int bx = blockIdx.x; F.vcu = (F.G % 8 == 0) ? (bx % 8) * (F.G / 8) + bx / 8 : bx; }
    F.ws = args.ws; F.ctl = (gu32*)(args.ws + WS_CTL); F.out = args.out;
    for (int u = F.tid; u < 256; u += NWAVES * 64) ((LAS unsigned*)(F.lds + LDSCTL_OFF))[u] = 0u;
    __syncthreads();
    const int lo = args.lo, hi = args.hi;
    XcdBarrier bar; bar.bar = (unsigned*)(F.ctl + CW_BAR); bar.x = 0; bar.st = nullptr;
    if (hi - lo > 1) bar = xcd_barrier_post((unsigned*)(F.ctl + CW_BAR), F.MISC + 8);
    int step = 0;
#define RUN_STEP(body) do { if (step >= lo && step < hi) { asm volatile("" : "+v"(F.tid)); asm volatile("" : "+v"(F.lane)); asm volatile("" : "+s"(F.wave)); asm volatile("" : "+s"(F.vcu));   body; if (step + 1 < hi) xcd_barrier(bar); } ++step; } while (0)
    LAS unsigned char* ring = F.lds + RING_OFF; LAS int* rowtab = (LAS int*)(F.lds + ROWTAB_OFF);
    unsigned char* ws = F.ws;
    const pg8::bf16_t* H = (const pg8::bf16_t*)(ws + WS_H); const pg8::bf16_t* MIXB = (const pg8::bf16_t*)(ws + WS_MIX);
    const float* MOD = (const float*)(ws + WS_MOD);

    RUN_STEP(EN_P0(p0_prologue(F)));
    for (int l = 0; l < DEPTH; ++l) {
        const float* modl = MOD + (size_t)l * 32 * NMOD; const float* modp = MOD + (size_t)(l > 0 ? l - 1 : 0) * 32 * NMOD;
        bf16* XB = (bf16*)F.out;
        bf16* XB2 = (bf16*)(ws + WS_XB2);
        if (l == 0)      RUN_STEP(EN_NORM((norm_phase<false, false, true, G1_FP8>(F, KARG(0), XB, KARG(2) + l * DM, modl, 0, DM, nullptr, nullptr, 0))));
        else if (l == 2) RUN_STEP(EN_NORM((norm_phase<true, false, false, G1_FP8>(F, XB, XB, KARG(2) + l * DM, modl, 0, DM, modp, nullptr, 0))));
        else             RUN_STEP(EN_NORM1((norm_phase<false, false, false, G1_FP8>(F, XB, nullptr, KARG(2) + l * DM, modl, 0, DM, nullptr, nullptr, 0))));
        RUN_STEP(({ pg8::Gemm g{H, (const pg8::bf16_t*)(ws + WS_WIN + (size_t)l * NPROJ * DM * (G1_FP8 ? 1 : 2)), G1_FP8 ? DM / 2 : DM}; pg8::StaticOrder S; S.init(T, NPROJ, F.G, (int)blockIdx.x);
                    pg8::EpiBf16 E{(pg8::bf16_t*)(ws + WS_PROJ), NPROJ}; EN_G1((pg8::gemm_phase<pg8::EpiBf16, pg8::StaticOrder, true, 0, G1_FP8, true, G1_FP8 ? DM / 2 : DM>(ring, rowtab, g, S, E))); }));
        RUN_STEP(EN_MX(mixer_phase(F, l)));
        RUN_STEP(({ pg8::Gemm g{MIXB, (const pg8::bf16_t*)(ws + WS_WOUT) + (size_t)l * DM * DM, DM}; pg8::StaticOrder S; S.init(T, DM, F.G, (int)blockIdx.x);
                    pg8::EpiResB E{XB, (l == DEPTH - 1) ? XB2 : XB, modl + 2 * DM, NMOD, 1.0f}; EN_G2((pg8::gemm_phase<pg8::EpiResB, pg8::StaticOrder, true, 0, false, true, DM>(ring, rowtab, g, S, E))); }));
        const bf16* XC = (l == DEPTH - 1) ? XB2 : XB;
        if ((l & 1) == 0) {
            const int i = l >> 1;
            RUN_STEP(EN_NORM((norm_phase<false, false, false, G3_FP8>(F, XC, nullptr, KARG(3) + l * DM, modl, 3 * DM, 4 * DM, nullptr, nullptr, 0))));
            RUN_STEP(({ pg8::Gemm g{H, (const pg8::bf16_t*)(ws + WS_W13D + (size_t)i * 2 * FF * DM * (G3_FP8 ? 1 : 2)), G3_FP8 ? DM / 2 : DM}; pg8::StaticOrder S; S.init(T, 2 * FF, F.G, (int)blockIdx.x);
                        using EpiG3 = typename pg8::SelT<G4_FP8, pg8::EpiSwiglu8, pg8::EpiSwiglu>::type;
                        EpiG3 E{(decltype(EpiG3::O))(ws + WS_HID), FF};
                        EN_G3((pg8::gemm_phase<EpiG3, pg8::StaticOrder, true, 0, G3_FP8, true, G3_FP8 ? DM / 2 : DM>(ring, rowtab, g, S, E))); }));
            RUN_STEP(({ pg8::Gemm g{(const pg8::bf16_t*)(ws + WS_HID), (const pg8::bf16_t*)(ws + WS_W2D + (size_t)i * DM * FF * (G4_FP8 ? 1 : 2)), G4_FP8 ? FF / 2 : FF}; pg8::StaticOrder S; S.init(T, DM, F.G, (int)blockIdx.x, 1);
                        pg8::EpiResB E{XB, XB, modl + 5 * DM, NMOD, G4_FP8 ? 1.0f / pg8::W2_8_SCALE : 1.0f}; EN_G4((pg8::gemm_phase<pg8::EpiResB, pg8::StaticOrder, true, 0, G4_FP8, !G4_FP8, G4_FP8 ? FF / 2 : FF>(ring, rowtab, g, S, E))); }));
        } else {
            const int i = l >> 1;
            RUN_STEP(EN_NORM((norm_phase<false, true, false, true>(F, XC, nullptr, KARG(3) + l * DM, modl, 3 * DM, 4 * DM, nullptr, KARG(21) + (size_t)i * DM * NE, i))));
            RUN_STEP(EN_NORM(route_phase(F, i)));
            int ps[9]; ps[0] = 0;
            if (step + N_CHUNK + 1 >= lo && step < hi) {
#pragma unroll
                for (int e = 0; e < 8; ++e) ps[e + 1] = ps[e] + __builtin_amdgcn_readfirstlane((int)((__hip_atomic_load(F.ctl + CW_MOE + i * 64 + e, RLX_AGENT) + 255u) >> 8));
            } else {
#pragma unroll
                for (int e = 0; e < 8; ++e) ps[e + 1] = 0;
            }
            constexpr size_t HIDC_BUF = (size_t)CH0_MAX * 256 * FFE;
            const int npx = ps[8] > N_CHUNK * CH_PAN ? (ps[8] - N_CHUNK * CH_PAN > CH0_MAX - CH_PAN ? CH0_MAX - CH_PAN : ps[8] - N_CHUNK * CH_PAN) : 0, nh8 = (F.G == 256) ? ((4 * npx + 7) & ~7) : 0;
#define MOE_GEOM(c_) const int pan0 = (c_) == 0 ? 0 : CH_PAN * (c_) + npx; int npan = ps[8] - pan0; { const int cap = (c_) == 0 ? CH_PAN + npx : CH_PAN; npan = npan < 0 ? 0 : (npan > cap ? cap : npan); }
#define MOE_UP(c_, nh_) do { MOE_GEOM(c_) \
                pg8::Gemm g{H, (const pg8::bf16_t*)(ws + WS_W13E + (size_t)i * W13E_LSTRIDE), DM / 2}; \
                pg8::MoeOrder<true> S; S.so.init(npan * 256, 2 * FFE, F.G, (int)blockIdx.x, 0, (nh_), MOE_HQ); S.pan0 = pan0; S.ps1 = ps[1]; S.ps2 = ps[2]; S.ps3 = ps[3]; S.ps4 = ps[4]; S.ps5 = ps[5]; S.ps6 = ps[6]; S.ps7 = ps[7]; \
                S.estride = (size_t)2 * FFE * DM; S.rowmap = (const int*)(ws + WS_RM); \
                pg8::EpiSwiglu8 E{ws + WS_HIDC + ((c_) & 1) * HIDC_BUF, FFE}; EN_UP((pg8::gemm_phase<pg8::EpiSwiglu8, pg8::MoeOrder<true>, true, 0, true, true, DM / 2>(ring, rowtab, g, S, E))); } while (0)
#define MOE_DN(c_) do { MOE_GEOM(c_) \
                pg8::Gemm g{(const pg8::bf16_t*)(ws + WS_HIDC + ((c_) & 1) * HIDC_BUF), (const pg8::bf16_t*)(ws + WS_W2E + (size_t)i * 8 * DM * FFE), FFE / 2}; \
                pg8::MoeOrder<false> S; S.so.init(npan * 256, DM, F.G, (int)blockIdx.x, 1); S.pan0 = pan0; S.ps1 = ps[1]; S.ps2 = ps[2]; S.ps3 = ps[3]; S.ps4 = ps[4]; S.ps5 = ps[5]; S.ps6 = ps[6]; S.ps7 = ps[7]; \
                S.estride = (size_t)DM * FFE; S.rowmap = nullptr; \
                pg8::EpiBf16 E{(pg8::bf16_t*)(ws + WS_YS) + (size_t)pan0 * 256 * DM, DM}; EN_DN((pg8::gemm_phase<pg8::EpiBf16, pg8::MoeOrder<false>, true, 0, true, true, FFE / 2>(ring, rowtab, g, S, E))); } while (0)
            RUN_STEP(({ MOE_UP(0, 0); }));
            for (int c = 0; c < N_CHUNK; ++c) {
                RUN_STEP(({ MOE_DN(c); if (c + 1 < N_CHUNK) { MOE_UP(c + 1, c == 0 ? nh8 : 0); } }));
            }
#undef MOE_GEOM
#undef MOE_UP
#undef MOE_DN
        }
    }
    RUN_STEP(EN_FINAL(final_phase(F, MOD + (size_t)3 * 32 * NMOD, (const bf16*)(ws + WS_XB2))));
#undef RUN_STEP
}

#ifndef N_LAUNCH_MODE
#define N_LAUNCH_MODE 1
#endif
extern "C" void kernel_launch(void* const* d_in, const int* in_sizes, int n_in, void* d_out, int out_size, void* d_ws, size_t ws_size, hipStream_t stream) {
    static int grid = 0;
    if (grid == 0) {
        if (n_in != 25 || in_sizes[0] != T * DM || out_size != T * DM || ws_size < WS_END) { fprintf(stderr, "kernel_launch: unexpected shapes (n_in %d, in0 %d, out %d, ws %zu < %zu); nothing launched\n", n_in, n_in > 0 ? in_sizes[0] : -1, out_size, ws_size, (size_t)WS_END); grid = -1; return; }
        int dev = 0, cus = 0, per_cu = 0;
        if (hipGetDevice(&dev) != hipSuccess || hipDeviceGetAttribute(&cus, hipDeviceAttributeMultiprocessorCount, dev) != hipSuccess) { grid = -1; return; }
        if (hipFuncSetAttribute((const void*)fwd_kernel, hipFuncAttributeMaxDynamicSharedMemorySize, LDS_BYTES) != hipSuccess) { fprintf(stderr, "kernel_launch: hipFuncSetAttribute failed\n"); grid = -1; return; }
        if (hipOccupancyMaxActiveBlocksPerMultiprocessor(&per_cu, (const void*)fwd_kernel, NWAVES * 64, LDS_BYTES) != hipSuccess || per_cu < 1) fprintf(stderr, "kernel_launch: occupancy query says %d\n", per_cu);
        (void)hipGetLastError();
        grid = cus;
        if (grid != 256) fprintf(stderr, "kernel_launch: %d CUs (built for 256)\n", grid);
    }
    if (grid < 0) return;
    if (hipMemsetAsync((char*)d_ws + WS_CTL, 0, CTL_ZERO_BYTES, stream) != hipSuccess) return;
    Args a{};
    for (int i = 0; i < 25; ++i) a.in[i] = (const float*)d_in[i];
    a.out = (float*)d_out; a.ws = (unsigned char*)d_ws;
#if N_LAUNCH_MODE == 1
    a.lo = 0; a.hi = N_STEPS;
    hipLaunchKernelGGL(fwd_kernel, dim3(grid), dim3(NWAVES * 64), LDS_BYTES, stream, a);
#else
    for (int s = 0; s < N_STEPS; ++s) { a.lo = s; a.hi = s + 1; hipLaunchKernelGGL(fwd_kernel, dim3(grid), dim3(NWAVES * 64), LDS_BYTES, stream, a); }
#endif
}
```
